# Optimizing an MI355X kernel written in HIP

```python
import jax, jax.numpy as jnp
from jax import lax
import numpy as np

D_MODEL = 1024
BATCH = 8
SEQ = 4096
DEPTH = 1

GRID_W = 64
CTX_LEN = 256
D_MIX = D_MODEL
D_REC = D_MIX // 2
D_ATT = D_MIX - D_REC
HEAD_DIM = 64
N_ATT_HEADS = D_ATT // HEAD_DIM
N_REC_BLOCKS = 8
REC_BLOCK = D_REC // N_REC_BLOCKS
CONV_W = 4
CONV_PAD_LEFT = 2
LRU_C = 8.0
WIN_ROWS = 8
WIN_COLS = 16
D_FF = 2816
N_MOD = 9
RES_W_FFN = 0.5
EPS = 1e-6
NEG_INF = -1e30
C_RG = D_REC
C_Q = 2 * D_REC
C_K = C_Q + D_ATT
C_V = C_K + D_ATT
D_IN = C_V + D_ATT

kernel_name = "hybrid_rglru_natten_macaron_dit_layer"


def rmsnorm(x, g):
    xf = x.astype(jnp.float32)
    y = xf * lax.rsqrt(jnp.mean(xf * xf, axis=-1, keepdims=True) + EPS)
    return (y * g.astype(jnp.float32)).astype(x.dtype)


def modulated_norm(x, g, mod, idx):
    shift = mod[:, 3 * idx][:, None]
    scale = mod[:, 3 * idx + 1][:, None]
    return rmsnorm(x, g) * (1.0 + scale) + shift


def gated_residual(x, y, g, mod, idx, res_w):
    gate = mod[:, 3 * idx + 2][:, None]
    return x + res_w * gate * rmsnorm(y, g)


def sublayer(x, mod, idx, g_pre, g_post, fn, res_w):
    return gated_residual(x, fn(modulated_norm(x, g_pre, mod, idx)), g_post, mod, idx, res_w)


def swiglu(h, w_gu, w_down):
    g, u = jnp.split(h @ w_gu, 2, axis=-1)
    return (jax.nn.silu(g) * u) @ w_down


def centred_dwconv(x, w, b):
    y = lax.conv_general_dilated(
        x, w[:, None, :], window_strides=(1,),
        padding=[(CONV_PAD_LEFT, CONV_W - 1 - CONV_PAD_LEFT)],
        dimension_numbers=("NWC", "WIO", "NWC"), feature_group_count=x.shape[-1])
    return y + b


def linear_scan(a, u, h0, reverse):
    def combine(left, right):
        a_l, b_l = left
        a_r, b_r = right
        return a_l * a_r, a_r * b_l + b_r
    a_cum, b_cum = lax.associative_scan(combine, (a, u), reverse=reverse, axis=1)
    return a_cum * h0[:, None] + b_cum


def rglru_direction(x, wa, ba, wx, bx, lam, h0, reverse):
    b, t, _ = x.shape
    xb = x.reshape(b, t, N_REC_BLOCKS, REC_BLOCK)
    gate_a = jnp.einsum("btnc,ncd->btnd", xb, wa).reshape(b, t, D_REC) + ba
    gate_x = jnp.einsum("btnc,ncd->btnd", xb, wx).reshape(b, t, D_REC) + bx
    log_a = LRU_C * jax.nn.sigmoid(gate_a.astype(jnp.float32)) * jax.nn.log_sigmoid(lam.astype(jnp.float32))
    u = jnp.sqrt(-jnp.expm1(2.0 * log_a)) * jax.nn.sigmoid(gate_x.astype(jnp.float32)) * x.astype(jnp.float32)
    h = linear_scan(jnp.exp(log_a), u, h0, reverse)
    final = h[:, 0] if reverse else h[:, -1]
    return h, final


def rglru_group(xr, xr_ctx, conv_w, conv_b, wa, ba, wx, bx, lam, need_ctx_out):
    xl = centred_dwconv(xr, conv_w, conv_b)
    xc = centred_dwconv(xr_ctx, conv_w, conv_b)
    h0 = jnp.zeros((xc.shape[0], D_REC), jnp.float32)
    ys_lat, ys_ctx = [], []
    for d, rev in enumerate((False, True)):
        hc, h_fin = rglru_direction(xc, wa[d], ba[d], wx[d], bx[d], lam[d], h0, rev)
        hl, _ = rglru_direction(xl, wa[d], ba[d], wx[d], bx[d], lam[d], h_fin, rev)
        ys_lat.append(hl)
        ys_ctx.append(hc)
    y_lat = (ys_lat[0] + ys_lat[1]).astype(xr.dtype)
    y_ctx = (ys_ctx[0] + ys_ctx[1]).astype(xr.dtype) if need_ctx_out else None
    return y_lat, y_ctx


def neighbourhood_attention(q, k, v, k_ctx, v_ctx, rpb):
    b, l = q.shape[:2]
    rows = l // GRID_W
    win_r = min(WIN_ROWS, rows)
    scale = HEAD_DIM ** -0.5

    def to_grid(t):
        return t.reshape(b, rows, GRID_W, N_ATT_HEADS, HEAD_DIM).transpose(0, 3, 1, 2, 4)

    qg, kg, vg = to_grid(q), to_grid(k), to_grid(v)
    col = np.arange(GRID_W)
    col_start = np.clip(col - WIN_COLS // 2, 0, GRID_W - WIN_COLS)
    col_valid = (col[None, :] >= col_start[:, None]) & (col[None, :] < col_start[:, None] + WIN_COLS)
    col_off = np.clip(col[None, :] - col[:, None] + WIN_COLS - 1, 0, 2 * WIN_COLS - 2)
    rpb_cols = rpb.astype(jnp.float32)[:, :, col_off]

    def one_row(args):
        r, q_row = args
        start = jnp.clip(r - win_r // 2, 0, rows - win_r)
        k_band = lax.dynamic_slice_in_dim(kg, start, win_r, axis=2)
        v_band = lax.dynamic_slice_in_dim(vg, start, win_r, axis=2)
        s_loc = jnp.einsum("bhqd,bhjkd->bhqjk", q_row, k_band).astype(jnp.float32) * scale
        row_off = start + jnp.arange(win_r) - r + WIN_ROWS - 1
        bias = jnp.take(rpb_cols, row_off, axis=1).transpose(0, 2, 1, 3)
        s_loc = jnp.where(col_valid[:, None, :], s_loc + bias, NEG_INF)
        s_ctx = jnp.einsum("bhqd,bhkd->bhqk", q_row, k_ctx).astype(jnp.float32) * scale
        s = jnp.concatenate([s_loc.reshape(b, N_ATT_HEADS, GRID_W, win_r * GRID_W), s_ctx], axis=-1)
        p = jax.nn.softmax(s, axis=-1)
        p_loc = p[..., :win_r * GRID_W].reshape(b, N_ATT_HEADS, GRID_W, win_r, GRID_W).astype(v.dtype)
        p_ctx = p[..., win_r * GRID_W:].astype(v.dtype)
        return (jnp.einsum("bhqjk,bhjkd->bhqd", p_loc, v_band)
                + jnp.einsum("bhqk,bhkd->bhqd", p_ctx, v_ctx))

    out = lax.map(one_row, (jnp.arange(rows), qg.transpose(2, 0, 1, 3, 4)))
    return out.transpose(1, 0, 3, 2, 4).reshape(b, l, D_ATT)


def context_attention(q_ctx, k_ctx, v_ctx):
    s = jnp.einsum("bhqd,bhkd->bhqk", q_ctx, k_ctx).astype(jnp.float32) * HEAD_DIM ** -0.5
    p = jax.nn.softmax(s, axis=-1).astype(v_ctx.dtype)
    o = jnp.einsum("bhqk,bhkd->bhqd", p, v_ctx)
    b, _, t, _ = o.shape
    return o.transpose(0, 2, 1, 3).reshape(b, t, D_ATT)


def split_heads(t):
    return t.reshape(t.shape[0], t.shape[1], N_ATT_HEADS, HEAD_DIM)


def mixer(h, hc, w_in, w_out, conv_w, conv_b, wa, ba, wx, bx, lam, rpb, need_ctx_out):
    p = h @ w_in
    xr, gr, q, k, v = p[..., :C_RG], p[..., C_RG:C_Q], p[..., C_Q:C_K], p[..., C_K:C_V], p[..., C_V:]
    xr_ctx = hc @ w_in[:, :C_RG]
    kv_ctx = hc @ w_in[:, C_K:]
    k_ctx = split_heads(kv_ctx[..., :D_ATT]).transpose(0, 2, 1, 3)
    v_ctx = split_heads(kv_ctx[..., D_ATT:]).transpose(0, 2, 1, 3)

    y_rec, y_rec_ctx = rglru_group(xr, xr_ctx, conv_w, conv_b, wa, ba, wx, bx, lam, need_ctx_out)
    y_att = neighbourhood_attention(split_heads(q), split_heads(k), split_heads(v), k_ctx, v_ctx, rpb)
    y = jnp.concatenate([y_rec * jax.nn.gelu(gr), y_att], axis=-1) @ w_out
    if not need_ctx_out:
        return y, None
    g_ctx = hc @ w_in[:, C_RG:C_Q]
    q_ctx = split_heads(hc @ w_in[:, C_Q:C_K]).transpose(0, 2, 1, 3)
    y_att_ctx = context_attention(q_ctx, k_ctx, v_ctx)
    yc = jnp.concatenate([y_rec_ctx * jax.nn.gelu(g_ctx), y_att_ctx], axis=-1) @ w_out
    return y, yc


def setup_inputs(seed: int = 0) -> dict:
    key = jax.random.key(seed)
    ks = jax.random.split(key, 24)
    nrm = jax.random.normal
    f32 = jnp.float32
    lam_u = jax.random.uniform(ks[20], (DEPTH, 2, D_REC), f32, 0.9, 0.999)
    a0 = lam_u ** (1.0 / LRU_C)
    return {
        "x": nrm(ks[0], (BATCH, SEQ, D_MODEL), f32),
        "c": nrm(ks[1], (BATCH, D_MODEL), f32),
        "ctx": nrm(ks[2], (BATCH, CTX_LEN, D_MODEL), f32),
        "c_ctx": nrm(ks[3], (D_MODEL,), f32),
        "w_mod": nrm(ks[4], (DEPTH, D_MODEL, N_MOD * D_MODEL), f32) * D_MODEL ** -0.5,
        "b_mod": nrm(ks[5], (DEPTH, N_MOD * D_MODEL), f32) * 0.02,
        "norm_pre": 1.0 + 0.05 * nrm(ks[6], (DEPTH, 3, D_MODEL), f32),
        "norm_post": 1.0 + 0.05 * nrm(ks[7], (DEPTH, 3, D_MODEL), f32),
        "ffn1_w_gu": nrm(ks[8], (DEPTH, D_MODEL, 2 * D_FF), f32) * D_MODEL ** -0.5,
        "ffn1_w_down": nrm(ks[9], (DEPTH, D_FF, D_MODEL), f32) * D_FF ** -0.5,
        "ffn2_w_gu": nrm(ks[10], (DEPTH, D_MODEL, 2 * D_FF), f32) * D_MODEL ** -0.5,
        "ffn2_w_down": nrm(ks[11], (DEPTH, D_FF, D_MODEL), f32) * D_FF ** -0.5,
        "w_in": nrm(ks[12], (DEPTH, D_MODEL, D_IN), f32) * D_MODEL ** -0.5,
        "w_out": nrm(ks[13], (DEPTH, D_MIX, D_MODEL), f32) * D_MIX ** -0.5,
        "conv_w": nrm(ks[14], (DEPTH, CONV_W, D_REC), f32) * CONV_W ** -0.5,
        "conv_b": nrm(ks[15], (DEPTH, D_REC), f32) * 0.02,
        "lru_wa": nrm(ks[16], (DEPTH, 2, N_REC_BLOCKS, REC_BLOCK, REC_BLOCK), f32) * REC_BLOCK ** -0.5,
        "lru_ba": nrm(ks[17], (DEPTH, 2, D_REC), f32) * 0.02,
        "lru_wx": nrm(ks[18], (DEPTH, 2, N_REC_BLOCKS, REC_BLOCK, REC_BLOCK), f32) * REC_BLOCK ** -0.5,
        "lru_bx": nrm(ks[19], (DEPTH, 2, D_REC), f32) * 0.02,
        "lru_lambda": jnp.log(a0) - jnp.log1p(-a0),
        "na_rpb": nrm(ks[21], (DEPTH, N_ATT_HEADS, 2 * WIN_ROWS - 1, 2 * WIN_COLS - 1), f32) * 0.1,
    }


def reference(x, c, ctx, c_ctx, w_mod, b_mod, norm_pre, norm_post, ffn1_w_gu, ffn1_w_down,
              ffn2_w_gu, ffn2_w_down, w_in, w_out, conv_w, conv_b, lru_wa, lru_ba, lru_wx,
              lru_bx, lru_lambda, na_rpb):
    b = x.shape[0]
    xc = ctx
    for l in range(DEPTH):
        last = l == DEPTH - 1
        mod = (jax.nn.silu(c) @ w_mod[l] + b_mod[l]).reshape(b, N_MOD, D_MODEL)
        mod_c = (jax.nn.silu(c_ctx)[None] @ w_mod[l] + b_mod[l]).reshape(1, N_MOD, D_MODEL)
        ffn1 = lambda h: swiglu(h, ffn1_w_gu[l], ffn1_w_down[l])
        ffn2 = lambda h: swiglu(h, ffn2_w_gu[l], ffn2_w_down[l])

        x = sublayer(x, mod, 0, norm_pre[l, 0], norm_post[l, 0], ffn1, RES_W_FFN)
        xc = sublayer(xc, mod_c, 0, norm_pre[l, 0], norm_post[l, 0], ffn1, RES_W_FFN)

        h = modulated_norm(x, norm_pre[l, 1], mod, 1)
        hc = modulated_norm(xc, norm_pre[l, 1], mod_c, 1)
        y, yc = mixer(h, hc, w_in[l], w_out[l], conv_w[l], conv_b[l], lru_wa[l], lru_ba[l],
                      lru_wx[l], lru_bx[l], lru_lambda[l], na_rpb[l], need_ctx_out=not last)
        x = gated_residual(x, y, norm_post[l, 1], mod, 1, 1.0)
        if not last:
            xc = gated_residual(xc, yc, norm_post[l, 1], mod_c, 1, 1.0)

        x = sublayer(x, mod, 2, norm_pre[l, 2], norm_post[l, 2], ffn2, RES_W_FFN)
        if not last:
            xc = sublayer(xc, mod_c, 2, norm_pre[l, 2], norm_post[l, 2], ffn2, RES_W_FFN)
    return x
```

```cpp
#include <hip/hip_runtime.h>
#include <stdint.h>

typedef unsigned short bf16_t;
typedef short bf16x8 __attribute__((ext_vector_type(8)));
typedef float f32x4 __attribute__((ext_vector_type(4)));

constexpr int NB = 8, T = 4096, D = 1024, CT = 256, DFF = 2816, DIN = 2560, DREC = 512, NMOD = 9;
constexpr int ML = NB * T, MC = NB * CT, MT = ML + MC;
constexpr float EPS = 1e-6f;
constexpr size_t MiB = 1u << 20;
constexpr size_t WS_MOD = 0, WS_A = 1 * MiB, WS_ACT = 69 * MiB, WS_F = 256 * MiB, WS_YREC = 392 * MiB;

__device__ __forceinline__ unsigned f2bf(float f) { unsigned u = __builtin_bit_cast(unsigned, f); return (u + 0x7fffu + ((u >> 16) & 1u)) >> 16; }
__device__ __forceinline__ float bf2f(unsigned short h) { return __builtin_bit_cast(float, (unsigned)h << 16); }
__device__ __forceinline__ float sigmoidf_(float x) { return 1.f / (1.f + __expf(-x)); }
__device__ __forceinline__ float wave_sum(float v) {
#pragma unroll
    for (int o = 1; o < 64; o <<= 1) v += __shfl_xor(v, o);
    return v;
}
__device__ __forceinline__ float wave_max(float v) {
#pragma unroll
    for (int o = 1; o < 64; o <<= 1) v = fmaxf(v, __shfl_xor(v, o));
    return v;
}

__global__ void k_mod(const float* c, const float* cctx, const float* wmod, const float* bmod, float* mod) {
    const int j = blockIdx.x * 256 + threadIdx.x, r = blockIdx.y;
    const float* cv = r < 8 ? c + r * D : cctx;
    float acc = 0.f;
    for (int k = 0; k < D; ++k) { const float v = cv[k]; acc += (v * sigmoidf_(v)) * wmod[(size_t)k * (NMOD * D) + j]; }
    mod[r * (NMOD * D) + j] = acc + bmod[j];
}

__device__ __forceinline__ void store_modnorm(const f32x4 (&v)[4], const float* modrow, int idx, const float* gpre, bf16_t* arow, int lane) {
    float ss = 0.f;
#pragma unroll
    for (int j = 0; j < 4; ++j) ss += v[j].x * v[j].x + v[j].y * v[j].y + v[j].z * v[j].z + v[j].w * v[j].w;
    const float rs = rsqrtf(wave_sum(ss) * (1.f / D) + EPS);
    const float* sh = modrow + (3 * idx) * D; const float* sc = modrow + (3 * idx + 1) * D;
#pragma unroll
    for (int j = 0; j < 4; ++j) {
        const int e = 4 * (lane + 64 * j);
        const f32x4 g = *(const f32x4*)(gpre + e), s1 = *(const f32x4*)(sc + e), s0 = *(const f32x4*)(sh + e);
        f32x4 o;
        o.x = v[j].x * rs * g.x * (1.f + s1.x) + s0.x; o.y = v[j].y * rs * g.y * (1.f + s1.y) + s0.y;
        o.z = v[j].z * rs * g.z * (1.f + s1.z) + s0.z; o.w = v[j].w * rs * g.w * (1.f + s1.w) + s0.w;
        uint2 w; w.x = f2bf(o.x) | (f2bf(o.y) << 16); w.y = f2bf(o.z) | (f2bf(o.w) << 16);
        *(uint2*)(arow + e) = w;
    }
}
__global__ void k_prenorm(const float* xl, const float* xc, const float* mod, int idx, const float* gpre, bf16_t* A) {
    const int row = blockIdx.x * 4 + (threadIdx.x >> 6), lane = threadIdx.x & 63;
    if (row >= MT) return;
    const float* src = row < ML ? xl + (size_t)row * D : xc + (size_t)(row - ML) * D;
    const float* modrow = mod + (size_t)(row < ML ? row / T : 8) * (NMOD * D);
    f32x4 v[4];
#pragma unroll
    for (int j = 0; j < 4; ++j) v[j] = *(const f32x4*)(src + 4 * (lane + 64 * j));
    store_modnorm(v, modrow, idx, gpre, A + (size_t)row * D, lane);
}
__global__ void k_resnorm(const float* F, const float* xl, const float* xc, const float* mod, int idx, const float* gpost, float res_w,
                          float* xout, int nidx, const float* gpre_n, bf16_t* A, int M) {
    const int row = blockIdx.x * 4 + (threadIdx.x >> 6), lane = threadIdx.x & 63;
    if (row >= M) return;
    const float* src = row < ML ? xl + (size_t)row * D : xc + (size_t)(row - ML) * D;
    const float* modrow = mod + (size_t)(row < ML ? row / T : 8) * (NMOD * D);
    const float* gate = modrow + (3 * idx + 2) * D;
    f32x4 f[4], v[4]; float ss = 0.f;
#pragma unroll
    for (int j = 0; j < 4; ++j) { f[j] = *(const f32x4*)(F + (size_t)row * D + 4 * (lane + 64 * j)); ss += f[j].x * f[j].x + f[j].y * f[j].y + f[j].z * f[j].z + f[j].w * f[j].w; }
    const float rs = rsqrtf(wave_sum(ss) * (1.f / D) + EPS);
#pragma unroll
    for (int j = 0; j < 4; ++j) {
        const int e = 4 * (lane + 64 * j);
        const f32x4 xo = *(const f32x4*)(src + e), g = *(const f32x4*)(gpost + e), gt = *(const f32x4*)(gate + e);
        v[j].x = xo.x + res_w * gt.x * (f[j].x * rs * g.x); v[j].y = xo.y + res_w * gt.y * (f[j].y * rs * g.y);
        v[j].z = xo.z + res_w * gt.z * (f[j].z * rs * g.z); v[j].w = xo.w + res_w * gt.w * (f[j].w * rs * g.w);
        if (xout && row < ML) *(f32x4*)(xout + (size_t)row * D + e) = v[j];
    }
    if (nidx >= 0) store_modnorm(v, modrow, nidx, gpre_n, A + (size_t)row * D, lane);
}

template <int EPI>
__global__ __launch_bounds__(256) void k_gemm(const bf16_t* A, int lda, const float* W, int ldw, int K, void* out, int ldo, int ucol_off) {
    __shared__ __attribute__((aligned(16))) bf16_t sA[64][40];
    __shared__ __attribute__((aligned(16))) bf16_t sB[64][40];
    __shared__ __attribute__((aligned(16))) bf16_t sB2[64][40];
    const int m0 = blockIdx.y * 64, n0 = blockIdx.x * 64, tid = threadIdx.x, wave = tid >> 6, lane = tid & 63, r16 = lane & 15, quad = lane >> 4;
    f32x4 acc[4], acc2[4];
#pragma unroll
    for (int i = 0; i < 4; ++i) { acc[i] = (f32x4){0.f, 0.f, 0.f, 0.f}; acc2[i] = (f32x4){0.f, 0.f, 0.f, 0.f}; }
    for (int k0 = 0; k0 < K; k0 += 32) {
        { const int row = tid >> 2, ch = tid & 3; *(uint4*)&sA[row][ch * 8] = *(const uint4*)(A + (size_t)(m0 + row) * lda + k0 + ch * 8); }
        { const int nn = tid & 63, kk0 = tid >> 6;
#pragma unroll
          for (int i = 0; i < 8; ++i) { const int kk = kk0 + 4 * i; const float* wp = W + (size_t)(k0 + kk) * ldw + n0 + nn;
              sB[nn][kk] = (bf16_t)f2bf(wp[0]); if (EPI == 0) sB2[nn][kk] = (bf16_t)f2bf(wp[ucol_off]); } }
        __syncthreads();
        const bf16x8 a = *(const bf16x8*)&sA[wave * 16 + r16][quad * 8];
#pragma unroll
        for (int nt = 0; nt < 4; ++nt) {
            const bf16x8 b = *(const bf16x8*)&sB[nt * 16 + r16][quad * 8];
            acc[nt] = __builtin_amdgcn_mfma_f32_16x16x32_bf16(a, b, acc[nt], 0, 0, 0);
            if (EPI == 0) { const bf16x8 b2 = *(const bf16x8*)&sB2[nt * 16 + r16][quad * 8]; acc2[nt] = __builtin_amdgcn_mfma_f32_16x16x32_bf16(a, b2, acc2[nt], 0, 0, 0); }
        }
        __syncthreads();
    }
#pragma unroll
    for (int nt = 0; nt < 4; ++nt)
#pragma unroll
        for (int j = 0; j < 4; ++j) {
            const int row = m0 + wave * 16 + quad * 4 + j, col = n0 + nt * 16 + r16;
            if (EPI == 0) { const float g = acc[nt][j], u = acc2[nt][j]; ((bf16_t*)out)[(size_t)row * ldo + col] = (bf16_t)f2bf(g * sigmoidf_(g) * u); }
            else if (EPI == 1) ((float*)out)[(size_t)row * ldo + col] = acc[nt][j];
            else ((bf16_t*)out)[(size_t)row * ldo + col] = (bf16_t)f2bf(acc[nt][j]);
        }
}

__global__ __launch_bounds__(512) void k_gates(const bf16_t* P, const float* cw, const float* cb, const float* wa, const float* ba, const float* wx, const float* bx,
                                               const float* lam, int dir, float* Aa, float* Uu) {
    __shared__ float xl[DREC];
    const int R = blockIdx.x, ch = threadIdx.x;
    int t, Tlen, base;
    if (R < ML) { t = R % T; Tlen = T; base = R - t; } else { t = (R - ML) % CT; Tlen = CT; base = R - t; }
    float acc = cb[ch];
#pragma unroll
    for (int k = 0; k < 4; ++k) { const int tt = t + k - 2; if (tt >= 0 && tt < Tlen) acc += bf2f(P[(size_t)(base + tt) * DIN + ch]) * cw[k * DREC + ch]; }
    xl[ch] = acc;
    __syncthreads();
    const int n = ch >> 6, dl = ch & 63;
    const float* wap = wa + ((size_t)(dir * 8 + n) * 64) * 64 + dl; const float* wxp = wx + ((size_t)(dir * 8 + n) * 64) * 64 + dl;
    float ga = ba[dir * DREC + ch], gx = bx[dir * DREC + ch];
    for (int c = 0; c < 64; ++c) { const float xv = xl[n * 64 + c]; ga += xv * wap[c * 64]; gx += xv * wxp[c * 64]; }
    const float lm = lam[dir * DREC + ch];
    const float logsig = -log1pf(expf(-lm));
    const float log_a = 8.0f * sigmoidf_(ga) * logsig;
    const float a = expf(log_a);
    const float u = sqrtf(-expm1f(2.0f * log_a)) * sigmoidf_(gx) * acc;
    Aa[(size_t)R * DREC + ch] = a; Uu[(size_t)R * DREC + ch] = u;
}
__global__ void k_scan(const float* Aa, const float* Uu, int dir, float* Y) {
    const int ch = blockIdx.x * 64 + threadIdx.x, b = blockIdx.y;
    float h = 0.f;
    if (dir == 0) {
        for (int t = 0; t < CT; ++t) { const size_t i = (size_t)(ML + b * CT + t) * DREC + ch; h = Aa[i] * h + Uu[i]; }
        for (int t = 0; t < T; ++t) { const size_t i = (size_t)(b * T + t) * DREC + ch; h = Aa[i] * h + Uu[i]; Y[i] = h; }
    } else {
        for (int t = CT - 1; t >= 0; --t) { const size_t i = (size_t)(ML + b * CT + t) * DREC + ch; h = Aa[i] * h + Uu[i]; }
        for (int t = T - 1; t >= 0; --t) { const size_t i = (size_t)(b * T + t) * DREC + ch; h = Aa[i] * h + Uu[i]; Y[i] += h; }
    }
}
__device__ __forceinline__ float gelu_tanh(float x) { const float z = 0.7978845608028654f * (x + 0.044715f * x * x * x); return x * sigmoidf_(2.f * z); }
__global__ void k_recout(const float* Y, const bf16_t* P, bf16_t* Yout) {
    const size_t i = (size_t)blockIdx.x * 256 + threadIdx.x; const int ch = (int)(i % DREC); const size_t row = i / DREC;
    const float g = bf2f(P[row * DIN + DREC + ch]);
    Yout[row * D + ch] = (bf16_t)f2bf(Y[i] * gelu_tanh(g));
}

__global__ __launch_bounds__(256) void k_attn(const bf16_t* P, const float* rpb, bf16_t* Yout) {
    __shared__ float qs[4][64]; __shared__ float ps[4][384];
    const int wave = threadIdx.x >> 6, lane = threadIdx.x & 63;
    const int gq = blockIdx.x * 4 + wave;
    const int t = gq % T, h = (gq / T) % 8, b = gq / (T * 8);
    const int r = t / 64, c = t % 64;
    const int rs = min(max(r - 4, 0), 56), cs = min(max(c - 8, 0), 48);
    const size_t qrow = (size_t)(b * T + t);
    qs[wave][lane] = bf2f(P[qrow * DIN + 1024 + h * 64 + lane]);
    __syncthreads();
    float s[6]; float mx = -1e30f;
#pragma unroll
    for (int kk = 0; kk < 6; ++kk) {
        const int idx = lane + 64 * kk; size_t krow; float bias = 0.f;
        if (idx < 128) { const int kr = rs + (idx >> 4), kc = cs + (idx & 15); krow = (size_t)(b * T + kr * 64 + kc); bias = rpb[(h * 15 + (kr - r + 7)) * 31 + (kc - c + 15)]; }
        else krow = (size_t)(ML + b * CT + (idx - 128));
        const bf16_t* kp = P + krow * DIN + 1536 + h * 64;
        float acc = 0.f;
#pragma unroll
        for (int d8 = 0; d8 < 8; ++d8) { const uint4 kv = *(const uint4*)(kp + d8 * 8); const unsigned w[4] = {kv.x, kv.y, kv.z, kv.w};
#pragma unroll
            for (int e = 0; e < 4; ++e) { acc += qs[wave][d8 * 8 + 2 * e] * __builtin_bit_cast(float, w[e] << 16) + qs[wave][d8 * 8 + 2 * e + 1] * __builtin_bit_cast(float, w[e] & 0xffff0000u); } }
        s[kk] = acc * 0.125f + bias; mx = fmaxf(mx, s[kk]);
    }
    mx = wave_max(mx); float l = 0.f;
#pragma unroll
    for (int kk = 0; kk < 6; ++kk) { const float p = __expf(s[kk] - mx); l += p; ps[wave][lane + 64 * kk] = p; }
    l = wave_sum(l);
    __syncthreads();
    float o = 0.f;
    for (int idx = 0; idx < 384; ++idx) {
        size_t krow;
        if (idx < 128) { const int kr = rs + (idx >> 4), kc = cs + (idx & 15); krow = (size_t)(b * T + kr * 64 + kc); } else krow = (size_t)(ML + b * CT + (idx - 128));
        o += ps[wave][idx] * bf2f(P[krow * DIN + 2048 + h * 64 + lane]);
    }
    Yout[qrow * D + 512 + h * 64 + lane] = (bf16_t)f2bf(o / l);
}

extern "C" void kernel_launch(void* const* d_in, const int* in_sizes, int n_in, void* d_out, int out_size, void* d_ws, size_t ws_size, hipStream_t stream) {
    const float* x = (const float*)d_in[0]; const float* c = (const float*)d_in[1]; const float* ctx = (const float*)d_in[2]; const float* cctx = (const float*)d_in[3];
    const float* wmod = (const float*)d_in[4]; const float* bmod = (const float*)d_in[5]; const float* npre = (const float*)d_in[6]; const float* npost = (const float*)d_in[7];
    const float* gu1 = (const float*)d_in[8]; const float* dn1 = (const float*)d_in[9]; const float* gu2 = (const float*)d_in[10]; const float* dn2 = (const float*)d_in[11];
    const float* win = (const float*)d_in[12]; const float* wout = (const float*)d_in[13]; const float* cw = (const float*)d_in[14]; const float* cb = (const float*)d_in[15];
    const float* wa = (const float*)d_in[16]; const float* ba = (const float*)d_in[17]; const float* wx = (const float*)d_in[18]; const float* bx = (const float*)d_in[19];
    const float* lam = (const float*)d_in[20]; const float* rpb = (const float*)d_in[21];
    float* out = (float*)d_out; char* ws = (char*)d_ws;
    float* mod = (float*)(ws + WS_MOD); bf16_t* A = (bf16_t*)(ws + WS_A); bf16_t* ACT = (bf16_t*)(ws + WS_ACT); bf16_t* P = ACT;
    float* F = (float*)(ws + WS_F); float* Aa = F; float* Uu = F + (size_t)MT * DREC; float* YR = (float*)(ws + WS_YREC); bf16_t* Y = A;

    k_mod<<<dim3(NMOD * D / 256, 9), 256, 0, stream>>>(c, cctx, wmod, bmod, mod);
    k_prenorm<<<MT / 4, 256, 0, stream>>>(x, ctx, mod, 0, npre + 0 * D, A);
    k_gemm<0><<<dim3(DFF / 64, MT / 64), 256, 0, stream>>>(A, D, gu1, 2 * DFF, D, ACT, DFF, DFF);
    k_gemm<1><<<dim3(D / 64, MT / 64), 256, 0, stream>>>(ACT, DFF, dn1, D, DFF, F, D, 0);
    k_resnorm<<<MT / 4, 256, 0, stream>>>(F, x, ctx, mod, 0, npost + 0 * D, 0.5f, out, 1, npre + 1 * D, A, MT);
    k_gemm<2><<<dim3(DIN / 64, MT / 64), 256, 0, stream>>>(A, D, win, DIN, D, P, DIN, 0);
    for (int dir = 0; dir < 2; ++dir) {
        k_gates<<<MT, 512, 0, stream>>>(P, cw, cb, wa, ba, wx, bx, lam, dir, Aa, Uu);
        k_scan<<<dim3(DREC / 64, NB), 64, 0, stream>>>(Aa, Uu, dir, YR);
    }
    k_recout<<<(size_t)ML * DREC / 256, 256, 0, stream>>>(YR, P, Y);
    k_attn<<<NB * 8 * T / 4, 256, 0, stream>>>(P, rpb, Y);
    k_gemm<1><<<dim3(D / 64, ML / 64), 256, 0, stream>>>(Y, D, wout, D, D, F, D, 0);
    k_resnorm<<<ML / 4, 256, 0, stream>>>(F, out, ctx, mod, 1, npost + 1 * D, 1.0f, out, 2, npre + 2 * D, A, ML);
    k_gemm<0><<<dim3(DFF / 64, ML / 64), 256, 0, stream>>>(A, D, gu2, 2 * DFF, D, ACT, DFF, DFF);
    k_gemm<1><<<dim3(D / 64, ML / 64), 256, 0, stream>>>(ACT, DFF, dn2, D, DFF, F, D, 0);
    k_resnorm<<<ML / 4, 256, 0, stream>>>(F, out, ctx, mod, 2, npost + 2 * D, 0.5f, out, -1, nullptr, nullptr, ML);
}
```

```cpp
#include <hip/hip_runtime.h>
#include <stdint.h>
#include <cstdio>

namespace pg8 {
#define PG8_LAS __attribute__((address_space(3)))
typedef unsigned short bf16_t;
typedef short bf16x8 __attribute__((ext_vector_type(8)));
typedef float f32x4 __attribute__((ext_vector_type(4)));
typedef unsigned u32x4 __attribute__((ext_vector_type(4)));
constexpr int BM = 256, BK = 64, HALF = 128, HTB = HALF * BK * 2, STAGE_BYTES = 8 * HTB, NXCD = 8, WGM = 8;

__host__ __device__ __forceinline__ int lds_byte(int r, int c) { const int st = (r >> 4) * 2 + (c >> 5), rr = r & 15, cc = c & 31, ob = rr * 64 + cc * 2; return st * 1024 + (ob ^ (((ob >> 9) & 1) << 5)); }
__host__ __device__ __forceinline__ void stage_rc(int b, int& R, int& C) { const int st = b / 1024, sb = b % 1024, swz = sb ^ (((sb >> 9) & 1) << 5); R = (st >> 1) * 16 + swz / 64; C = (st & 1) * 32 + (swz % 64) / 2; }
__host__ __device__ __forceinline__ int perm32(int rho) { const int n = rho >> 4, i = rho & 15; return 8 * (i >> 2) + 4 * n + (i & 3); }

struct Unit { int pm, pn; };
struct Gemm { const bf16_t* A; const bf16_t* Bt; int M, N, K; };

struct StaticOrder {
    int nM, nN, nwg, G, c;
    __host__ __device__ void init(int M, int N, int G_, int c_) { nM = M / BM; nN = N / BM; nwg = nM * nN; G = G_; c = c_; }
    __host__ __device__ bool next(int i, Unit& u) const {
        const long L = (long)i * G + c; if (L >= nwg) return false;
        int wgid = (int)L; { const int q = nwg / NXCD, r = nwg % NXCD, xcd = wgid % NXCD, off = wgid / NXCD; wgid = (xcd < r ? xcd * (q + 1) : r * (q + 1) + (xcd - r) * q) + off; }
        const int nig = WGM * nN, gid = wgid / nig, fm = gid * WGM, gsz = (nM - fm) < WGM ? (nM - fm) : WGM;
        u.pm = fm + ((wgid % nig) % gsz); u.pn = (wgid % nig) / gsz; return true;
    }
    __device__ __forceinline__ void operands(const Gemm& g, const Unit& u, const char*& a, const char*& b) const {
        a = (const char*)g.A + (size_t)u.pm * (size_t)BM * g.K * 2; b = (const char*)g.Bt + (size_t)u.pn * (size_t)BM * g.K * 2; }
    __device__ __forceinline__ void a_ready(const Unit&) const {}
    __device__ __forceinline__ void done(const Unit&) const {}
};

__device__ __forceinline__ unsigned cvt_pk_bf16(float lo, float hi) { unsigned r; asm volatile("v_cvt_pk_bf16_f32 %0, %1, %2" : "=v"(r) : "v"(lo), "v"(hi)); return r; }

struct EpiF32 {
    static constexpr bool PERM = false, AFTER_DRAIN = false;
    float* C; int ldc;
    __device__ __forceinline__ void operator()(const f32x4 (&acc)[2][2][4][2], const Unit& u, int wr, int wc, int fr, int fq) const {
        const int row0 = u.pm * BM + wr * 64 + fr, col0 = u.pn * BM + wc * 32 + 4 * fq;
#pragma unroll
        for (int ai = 0; ai < 2; ++ai)
#pragma unroll
            for (int m = 0; m < 4; ++m) { float* rowp = C + (size_t)(row0 + ai * HALF + m * 16) * ldc + col0;
#pragma unroll
                for (int bj = 0; bj < 2; ++bj)
#pragma unroll
                    for (int n = 0; n < 2; ++n) *(f32x4*)(rowp + bj * HALF + n * 16) = acc[ai][bj][m][n]; }
    }
};
struct EpiBf16 {
    static constexpr bool PERM = true, AFTER_DRAIN = false;
    bf16_t* O; int ldc;
    __device__ __forceinline__ void operator()(const f32x4 (&acc)[2][2][4][2], const Unit& u, int wr, int wc, int fr, int fq) const {
        const int row0 = u.pm * BM + wr * 64 + fr, col0 = u.pn * BM + wc * 32 + 8 * fq;
#pragma unroll
        for (int ai = 0; ai < 2; ++ai)
#pragma unroll
            for (int m = 0; m < 4; ++m) { bf16_t* rowp = O + (size_t)(row0 + ai * HALF + m * 16) * ldc + col0;
#pragma unroll
                for (int bj = 0; bj < 2; ++bj) { const f32x4 v0 = acc[ai][bj][m][0], v1 = acc[ai][bj][m][1];
                    u32x4 w; w.x = cvt_pk_bf16(v0[0], v0[1]); w.y = cvt_pk_bf16(v0[2], v0[3]); w.z = cvt_pk_bf16(v1[0], v1[1]); w.w = cvt_pk_bf16(v1[2], v1[3]);
                    *(u32x4*)(rowp + bj * HALF) = w; } }
    }
};
__device__ __forceinline__ float silu_mul(float g, float u) { return g * u * __builtin_amdgcn_rcpf(1.f + __builtin_amdgcn_exp2f(-1.4426950408889634f * g)); }
struct EpiSwiGLU {
    static constexpr bool PERM = true, AFTER_DRAIN = false;
    bf16_t* O; int ldc;
    __device__ __forceinline__ void operator()(const f32x4 (&acc)[2][2][4][2], const Unit& u, int wr, int wc, int fr, int fq) const {
        const int row0 = u.pm * BM + wr * 64 + fr, col0 = u.pn * HALF + wc * 32 + 8 * fq;
#pragma unroll
        for (int ai = 0; ai < 2; ++ai)
#pragma unroll
            for (int m = 0; m < 4; ++m) { bf16_t* rowp = O + (size_t)(row0 + ai * HALF + m * 16) * ldc + col0;
                const f32x4 g0 = acc[ai][0][m][0], g1 = acc[ai][0][m][1], u0 = acc[ai][1][m][0], u1 = acc[ai][1][m][1];
                u32x4 w; w.x = cvt_pk_bf16(silu_mul(g0[0], u0[0]), silu_mul(g0[1], u0[1])); w.y = cvt_pk_bf16(silu_mul(g0[2], u0[2]), silu_mul(g0[3], u0[3]));
                w.z = cvt_pk_bf16(silu_mul(g1[0], u1[0]), silu_mul(g1[1], u1[1])); w.w = cvt_pk_bf16(silu_mul(g1[2], u1[2]), silu_mul(g1[3], u1[3]));
                *(u32x4*)rowp = w; }
    }
};

template <class Epi, class Sched, bool ALIGN_EPI = false, bool SP2 = false>
__device__ __forceinline__ void gemm_phase(PG8_LAS unsigned char* lds, const Gemm g, const Sched& S, const Epi& E) {
    const int tid = threadIdx.x, wid = __builtin_amdgcn_readfirstlane(tid >> 6), lane = tid & 63, wr = wid >> 2, wc = wid & 3, fr = lane & 15, fq = lane >> 4;
    const int K = g.K, nt = K / BK;
    unsigned voffA[2], voffB[2];
#pragma unroll
    for (int i = 0; i < 2; ++i) { int R, C; stage_rc(tid * 16 + i * 8192, R, C); const int Rb = Epi::PERM ? ((R & ~31) + perm32(R & 31)) : R;
        voffA[i] = (unsigned)(R * K + C) * 2u; voffB[i] = (unsigned)(Rb * K + C) * 2u; }
    const size_t kstep = (size_t)(BK * 2);
    const size_t hstep = (size_t)HALF * K * 2;
    const unsigned ldsw = (unsigned)wid * 1024u;
    const int aoff = lds_byte(wr * 64 + fr, fq * 8), boff = lds_byte(wc * 32 + fr, fq * 8);
#define PG8_SA(b, h) (((b) * 2 + (h)) * HTB)
#define PG8_SB(b, h) ((4 + (b) * 2 + (h)) * HTB)
#define PG8_STAGE(bufoff, gbase, voff) do { _Pragma("unroll") for (int _i = 0; _i < 2; ++_i) \
        __builtin_amdgcn_global_load_lds((const unsigned*)((const char*)(gbase) + (voff)[_i]), (PG8_LAS unsigned*)(lds + (bufoff) + ldsw + _i * 8192), 16, 0, 0); } while (0)
#define PG8_LDA(dst, b, h) do { _Pragma("unroll") for (int m = 0; m < 4; ++m) _Pragma("unroll") for (int k = 0; k < 2; ++k) dst[m][k] = *(const PG8_LAS bf16x8*)(lds + PG8_SA(b, h) + aoff + m * 2048 + k * 1024); } while (0)
#define PG8_LDB(dst, b, h) do { _Pragma("unroll") for (int n = 0; n < 2; ++n) _Pragma("unroll") for (int k = 0; k < 2; ++k) dst[n][k] = *(const PG8_LAS bf16x8*)(lds + PG8_SB(b, h) + boff + n * 2048 + k * 1024); } while (0)
#define PG8_MMA(ai, bj, At, Bt) do { __builtin_amdgcn_s_setprio(1); _Pragma("unroll") for (int m = 0; m < 4; ++m) _Pragma("unroll") for (int n = 0; n < 2; ++n) _Pragma("unroll") for (int k = 0; k < 2; ++k) \
        acc[ai][bj][m][n] = __builtin_amdgcn_mfma_f32_16x16x32_bf16(Bt[n][k], At[m][k], acc[ai][bj][m][n], 0, 0, 0); __builtin_amdgcn_s_setprio(0); } while (0)
#define PG8_WAIT_V(n) asm volatile("s_waitcnt vmcnt(" #n ")" ::: "memory")
#define PG8_WAIT_L(n) asm volatile("s_waitcnt lgkmcnt(" #n ")" ::: "memory")
#define PG8_BAR __builtin_amdgcn_s_barrier()
#define PG8_SCHED __builtin_amdgcn_sched_barrier(0)
    Unit cur, nxt; int ui = 0;
    if (!S.next(0, cur)) return;
    f32x4 acc[2][2][4][2];
#pragma unroll
    for (int a = 0; a < 2; ++a)
#pragma unroll
        for (int b = 0; b < 2; ++b)
#pragma unroll
            for (int m = 0; m < 4; ++m)
#pragma unroll
                for (int n = 0; n < 2; ++n) acc[a][b][m][n] = (f32x4){0.f, 0.f, 0.f, 0.f};
    bf16x8 At[4][2], B0[2][2], B1[2][2];
    const char* cA; const char* cB; S.operands(g, cur, cA, cB);
    S.a_ready(cur);
    if constexpr (SP2) {
        PG8_STAGE(PG8_SB(0, 0), cB, voffB); PG8_STAGE(PG8_SB(0, 1), cB + hstep, voffB); PG8_STAGE(PG8_SA(0, 0), cA, voffA); PG8_STAGE(PG8_SA(0, 1), cA + hstep, voffA);
        if (wr == 1) PG8_BAR;
        PG8_WAIT_V(2); PG8_BAR;
        PG8_STAGE(PG8_SB(1, 0), cB + kstep, voffB); PG8_STAGE(PG8_SA(1, 0), cA + kstep, voffA); PG8_STAGE(PG8_SB(1, 1), cB + hstep + kstep, voffB);
        PG8_WAIT_V(6); PG8_BAR;
    } else {
        PG8_STAGE(PG8_SB(0, 0), cB, voffB); PG8_STAGE(PG8_SA(0, 0), cA, voffA); PG8_STAGE(PG8_SB(0, 1), cB + hstep, voffB); PG8_STAGE(PG8_SA(0, 1), cA + hstep, voffA);
        if (wr == 1) PG8_BAR;
        PG8_WAIT_V(4); PG8_BAR;
        PG8_STAGE(PG8_SB(1, 0), cB + kstep, voffB); PG8_STAGE(PG8_SA(1, 0), cA + kstep, voffA); PG8_STAGE(PG8_SB(1, 1), cB + hstep + kstep, voffB);
        PG8_WAIT_V(6); PG8_BAR;
    }
    for (;;) {
        const bool has_next = S.next(ui + 1, nxt);
        const char* nA = cA; const char* nB = cB; if (has_next) S.operands(g, nxt, nA, nB);
        for (int t = 0; t < nt; t += 2) {
            const bool last = (t == nt - 2);
            const char* a1 = cA + (size_t)(t + 1) * kstep;
            const char* a2 = last ? nA : cA + (size_t)(t + 2) * kstep; const char* b2 = last ? nB : cB + (size_t)(t + 2) * kstep;
            const char* a3 = a2 + kstep; const char* b3 = b2 + kstep;
            if (last && has_next) S.a_ready(nxt);
            if constexpr (SP2) {
            PG8_LDB(B0, 0, 0); PG8_LDB(B1, 0, 1); PG8_SCHED; PG8_LDA(At, 0, 0); PG8_STAGE(PG8_SA(1, 1), a1 + hstep, voffA);
            PG8_WAIT_V(8); PG8_WAIT_L(0); PG8_BAR; PG8_MMA(0, 0, At, B0); PG8_MMA(0, 1, At, B1); PG8_BAR; PG8_SCHED;
            PG8_LDA(At, 0, 1); PG8_STAGE(PG8_SB(0, 0), b2, voffB); PG8_STAGE(PG8_SB(0, 1), b2 + hstep, voffB); PG8_STAGE(PG8_SA(0, 0), a2, voffA);
            PG8_WAIT_V(8); PG8_WAIT_L(0); PG8_BAR; PG8_MMA(1, 0, At, B0); PG8_MMA(1, 1, At, B1); PG8_BAR; PG8_SCHED;
            PG8_LDB(B0, 1, 0); PG8_LDB(B1, 1, 1); PG8_SCHED; PG8_LDA(At, 1, 0); PG8_STAGE(PG8_SA(0, 1), a2 + hstep, voffA);
            PG8_WAIT_V(8); PG8_WAIT_L(0); PG8_BAR; PG8_MMA(0, 0, At, B0); PG8_MMA(0, 1, At, B1); PG8_BAR; PG8_SCHED;
            PG8_LDA(At, 1, 1); PG8_STAGE(PG8_SB(1, 0), b3, voffB); PG8_STAGE(PG8_SB(1, 1), b3 + hstep, voffB); PG8_STAGE(PG8_SA(1, 0), a3, voffA);
            PG8_WAIT_V(8); PG8_WAIT_L(0); PG8_BAR; PG8_MMA(1, 0, At, B0); PG8_MMA(1, 1, At, B1); PG8_BAR; PG8_SCHED;
            } else {
            PG8_LDB(B0, 0, 0); PG8_SCHED; PG8_LDA(At, 0, 0); PG8_STAGE(PG8_SA(1, 1), a1 + hstep, voffA);
            PG8_WAIT_L(8); PG8_BAR; PG8_WAIT_L(0); PG8_MMA(0, 0, At, B0); PG8_BAR; PG8_SCHED;
            PG8_LDB(B1, 0, 1); PG8_STAGE(PG8_SB(0, 0), b2, voffB);
            PG8_BAR; PG8_WAIT_L(0); PG8_MMA(0, 1, At, B1); PG8_BAR;
            PG8_LDA(At, 0, 1); PG8_STAGE(PG8_SA(0, 0), a2, voffA);
            PG8_BAR; PG8_WAIT_L(0); PG8_MMA(1, 0, At, B0); PG8_BAR; PG8_SCHED;
            PG8_STAGE(PG8_SB(0, 1), b2 + hstep, voffB);
            PG8_WAIT_V(6); PG8_BAR; PG8_MMA(1, 1, At, B1); PG8_BAR;
            PG8_LDB(B0, 1, 0); PG8_SCHED; PG8_LDA(At, 1, 0); PG8_STAGE(PG8_SA(0, 1), a2 + hstep, voffA);
            PG8_WAIT_L(8); PG8_BAR; PG8_WAIT_L(0); PG8_MMA(0, 0, At, B0); PG8_BAR; PG8_SCHED;
            PG8_LDB(B1, 1, 1); PG8_STAGE(PG8_SB(1, 0), b3, voffB);
            PG8_BAR; PG8_WAIT_L(0); PG8_MMA(0, 1, At, B1); PG8_BAR;
            PG8_LDA(At, 1, 1); PG8_STAGE(PG8_SA(1, 0), a3, voffA);
            PG8_BAR; PG8_WAIT_L(0); PG8_MMA(1, 0, At, B0); PG8_BAR; PG8_SCHED;
            PG8_STAGE(PG8_SB(1, 1), b3 + hstep, voffB);
            PG8_WAIT_V(6); PG8_BAR; PG8_MMA(1, 1, At, B1); PG8_BAR;
            }
        }
        if constexpr (ALIGN_EPI) { if (wr == 0) PG8_BAR; }
        if constexpr (!Epi::AFTER_DRAIN) { E(acc, cur, wr, wc, fr, fq); S.done(cur); }
        if (!has_next) break;
#pragma unroll
        for (int a = 0; a < 2; ++a)
#pragma unroll
            for (int b = 0; b < 2; ++b)
#pragma unroll
                for (int m = 0; m < 4; ++m)
#pragma unroll
                    for (int n = 0; n < 2; ++n) acc[a][b][m][n] = (f32x4){0.f, 0.f, 0.f, 0.f};
        cur = nxt; cA = nA; cB = nB; ++ui;
        if constexpr (ALIGN_EPI) { if (wr == 1) PG8_BAR; }
    }
    PG8_WAIT_V(0);
    if constexpr (!ALIGN_EPI) { if (wr == 0) PG8_BAR; }
    PG8_BAR;
    if constexpr (Epi::AFTER_DRAIN) { E.fused(acc, cur, wr, wc, fr, fq, lds, wid, lane); S.done(cur); }
#undef PG8_SA
#undef PG8_SB
#undef PG8_STAGE
#undef PG8_LDA
#undef PG8_LDB
#undef PG8_MMA
#undef PG8_WAIT_V
#undef PG8_WAIT_L
#undef PG8_BAR
#undef PG8_SCHED
}
}

constexpr int NWAVES = 8;
constexpr int NB = 8, T = 4096, D = 1024, CT = 256, DFF = 2816, DIN = 2560, DREC = 512, NMOD = 9;
constexpr int ML = NB * T, MC = NB * CT, MT = ML + MC;
constexpr float EPS = 1e-6f;
constexpr size_t MiB = 1u << 20;
constexpr size_t WS_CTL = 0, CTL_ZERO_BYTES = 1 * MiB;
constexpr size_t WS_MOD = 1 * MiB;
constexpr size_t WS_WGU1 = 2 * MiB, WS_WD1 = 13 * MiB, WS_WGU2 = 19 * MiB, WS_WD2 = 30 * MiB, WS_WIN = 36 * MiB, WS_WOUT = 41 * MiB, WS_WG = 43 * MiB, WS_AGG = 44 * MiB;
constexpr size_t WS_A = 50 * MiB;
constexpr size_t WS_ACT = 118 * MiB;
constexpr size_t WS_F = 305 * MiB;
constexpr size_t WS_VT = 441 * MiB;
constexpr size_t WS_YREC = 441 * MiB;
constexpr size_t WS_END = 512 * MiB;
constexpr int CW_TMO = 0, CW_CODE = 1, CW_BAR = 4096;

constexpr int RING_OFF = 0, RING_BYTES = 131072;
constexpr int LDSCTL_OFF = RING_BYTES, MISC_OFF = LDSCTL_OFF + 320;
constexpr int LDS_BYTES = 147456;

#define GAS __attribute__((address_space(1)))
#define LAS __attribute__((address_space(3)))
typedef unsigned short bf16;
typedef unsigned v4u __attribute__((ext_vector_type(4)));
typedef float f32x4 __attribute__((ext_vector_type(4)));
typedef short bf16x8 __attribute__((ext_vector_type(8)));
typedef GAS unsigned gu32;
#define RLX_AGENT __ATOMIC_RELAXED, __HIP_MEMORY_SCOPE_AGENT
#define LDS_WAIT() asm volatile("s_waitcnt lgkmcnt(0)" ::: "memory")
#define VM_WAIT() asm volatile("s_waitcnt vmcnt(0)" ::: "memory")
__device__ __forceinline__ unsigned f2bf(float f) { unsigned u = __builtin_bit_cast(unsigned, f); return (u + 0x7fffu + ((u >> 16) & 1u)) >> 16; }
__device__ __forceinline__ unsigned pk2(float lo, float hi) { return f2bf(lo) | (f2bf(hi) << 16); }
__device__ __forceinline__ float bf2f(unsigned short h) { return __builtin_bit_cast(float, (unsigned)h << 16); }
__device__ __forceinline__ float sigmoidf_(float x) { return 1.f / (1.f + __expf(-x)); }
__device__ __forceinline__ float wave_sum(float v) {
#pragma unroll
    for (int o = 1; o < 64; o <<= 1) v += __shfl_xor(v, o);
    return v;
}
__device__ __forceinline__ float wave_max(float v) {
#pragma unroll
    for (int o = 1; o < 64; o <<= 1) v = fmaxf(v, __shfl_xor(v, o));
    return v;
}

#define XB_TMO      128
#define XB_XCNT(j)  (256  + 64 * (j))
#define XB_XSUB(j)  (1280 + 64 * (j))
#define XB_XGEN(j)  (2304 + 64 * (j))
#define XB_TOP      3328
#define XB_TOPGEN   3392
#define XCD_BAR_WORDS 3456
#define XB_SPIN_CAP (1u << 18)

__device__ __forceinline__ unsigned xb_ld(unsigned* p)              { return __hip_atomic_load(p, __ATOMIC_RELAXED, __HIP_MEMORY_SCOPE_AGENT); }
__device__ __forceinline__ unsigned xb_add(unsigned* p, unsigned v) { return __hip_atomic_fetch_add(p, v, __ATOMIC_RELAXED, __HIP_MEMORY_SCOPE_AGENT); }
__device__ __forceinline__ unsigned xb_xcc_id() { return (unsigned)__builtin_amdgcn_s_getreg((3 << 11) | 20) & 0xFu; }
#define XB_SPIN(cond, bar) do { unsigned _sp = 0; while (cond) { __builtin_amdgcn_s_sleep(1); \
    if ((++_sp & 255u) == 0u) { if (xb_ld(&(bar)[XB_TMO])) break; if (_sp > XB_SPIN_CAP) { atomicAdd(&(bar)[XB_TMO], 1u); break; } } } } while (0)

struct XcdBarrier {
    unsigned* bar; unsigned x;
    volatile LAS unsigned* st;
};

__device__ __forceinline__ XcdBarrier xcd_barrier_post(unsigned* bar, volatile LAS unsigned* st) {
    XcdBarrier b; b.bar = bar; b.x = xb_xcc_id(); b.st = st;
    if (threadIdx.x == 0) (void)xb_add(&bar[XB_XCNT(b.x)], 1u);
    return b;
}
__device__ __forceinline__ void xcd_barrier_complete(unsigned* bar, unsigned x, unsigned& nloc, unsigned& nx) {
    const unsigned G = gridDim.x * gridDim.y * gridDim.z;
    unsigned sum, cnt, mine, sp = 0u;
    for (;;) {
        sum = 0u; cnt = 0u; mine = 0u;
#pragma unroll
        for (unsigned j = 0; j < 16; ++j) { const unsigned c = xb_ld(&bar[XB_XCNT(j)]); sum += c; cnt += (c > 0u) ? 1u : 0u; mine = (j == x) ? c : mine; }
        if (sum == G) break;
        __builtin_amdgcn_s_sleep(1);
        if ((++sp & 255u) == 0u) { if (xb_ld(&bar[XB_TMO])) break; if (sp > XB_SPIN_CAP) { atomicAdd(&bar[XB_TMO], 1u); break; } }
    }
    nloc = mine > 0u ? mine : 1u; nx = cnt > 0u ? cnt : 1u;
}

__device__ __forceinline__ void xcd_barrier(const XcdBarrier& b) {
    asm volatile("s_waitcnt vmcnt(0)" ::: "memory");
    __syncthreads();
    if (threadIdx.x == 0) {
        unsigned* bar = b.bar;
        __builtin_amdgcn_s_waitcnt(0);
        unsigned nloc = b.st[0], nx = b.st[1];
        if (nloc == 0u) { xcd_barrier_complete(bar, b.x, nloc, nx); b.st[0] = nloc; b.st[1] = nx; }
        const unsigned old = xb_add(&bar[XB_XSUB(b.x)], 1u);
        const unsigned gen = old / nloc;
        if (old + 1u == (gen + 1u) * nloc) {
            __builtin_amdgcn_fence(__ATOMIC_RELEASE, "agent");
            asm volatile("s_waitcnt vmcnt(0)" ::: "memory");
            const unsigned og = xb_add(&bar[XB_TOP], 1u);
            const unsigned tg = og / nx;
            if (og + 1u == (tg + 1u) * nx) xb_add(&bar[XB_TOPGEN], 1u);
            else XB_SPIN(xb_ld(&bar[XB_TOPGEN]) == tg, bar);
            __builtin_amdgcn_fence(__ATOMIC_ACQUIRE, "agent");
            xb_add(&bar[XB_XGEN(b.x)], 1u);
            asm volatile("s_waitcnt vmcnt(0)" ::: "memory");
        } else {
            XB_SPIN(xb_ld(&bar[XB_XGEN(b.x)]) == gen, bar);
            __builtin_amdgcn_fence(__ATOMIC_ACQUIRE, "agent");
            asm volatile("s_waitcnt vmcnt(0)" ::: "memory");
        }
    }
    __syncthreads();
}

struct Frame {
    LAS unsigned char* lds;
    volatile LAS unsigned* MISC;
    gu32* ctl;
    int tid, lane, wave;
    int vcu, G;
};

__device__ __forceinline__ void p0_transpose_item(const float* W, int ldw, int K, bf16* WT, int drow0, int k0, int n0, LAS float* scr, int lane) {
#pragma unroll 8
    for (int i = 0; i < 32; ++i) { const int kk = 2 * i + (lane >> 5); scr[kk * 33 + (lane & 31)] = W[(size_t)(k0 + kk) * ldw + n0 + (lane & 31)]; }
    LDS_WAIT(); asm volatile("" ::: "memory");
    const int c = lane & 7;
#pragma unroll
    for (int j = 0; j < 4; ++j) { const int n = (lane >> 3) + 8 * j; const LAS float* s = scr + (8 * c) * 33 + n;
        v4u o; o.x = pk2(s[0 * 33], s[1 * 33]); o.y = pk2(s[2 * 33], s[3 * 33]); o.z = pk2(s[4 * 33], s[5 * 33]); o.w = pk2(s[6 * 33], s[7 * 33]);
        *(GAS v4u*)(WT + (size_t)(drow0 + n) * K + k0 + 8 * c) = o; }
    LDS_WAIT(); asm volatile("" ::: "memory");
}
__device__ __forceinline__ int gu_row(int n0) { const int u = n0 >= DFF ? 1 : 0, j = n0 - u * DFF; return 256 * (j >> 7) + 128 * u + (j & 127); }
__device__ __forceinline__ void p0_mod_item(const Frame& F, const float* c, const float* cctx, const float* wmod, const float* bmod, float* mod, int item) {
    LAS float* sl = (LAS float*)(F.lds + RING_OFF);
    LAS float* red = (LAS float*)(F.lds + RING_OFF + 49152);
    for (int i = F.tid; i < 9 * D; i += NWAVES * 64) { const int r = i >> 10, k = i & 1023; const float v = r < 8 ? c[r * D + k] : cctx[k]; sl[k * 12 + r] = v * sigmoidf_(v); }
    __syncthreads();
    const int j0 = item * 256;
    f32x4 acc[9];
#pragma unroll
    for (int r = 0; r < 9; ++r) acc[r] = (f32x4){0.f, 0.f, 0.f, 0.f};
    const float* wp = wmod + (size_t)(128 * F.wave) * (NMOD * D) + j0 + 4 * F.lane;
#pragma unroll 4
    for (int k = 0; k < 128; ++k) {
        const f32x4 w4 = *(const f32x4*)(wp + (size_t)k * (NMOD * D));
        const LAS f32x4* sp = (const LAS f32x4*)(sl + (128 * F.wave + k) * 12);
        const f32x4 s0 = sp[0], s1 = sp[1], s2 = sp[2];
        acc[0] += w4 * s0[0]; acc[1] += w4 * s0[1]; acc[2] += w4 * s0[2]; acc[3] += w4 * s0[3];
        acc[4] += w4 * s1[0]; acc[5] += w4 * s1[1]; acc[6] += w4 * s1[2]; acc[7] += w4 * s1[3];
        acc[8] += w4 * s2[0];
    }
#pragma unroll
    for (int r = 0; r < 9; ++r) *(LAS f32x4*)(red + (F.wave * 9 + r) * 256 + 4 * F.lane) = acc[r];
    __syncthreads();
    for (int idx = F.tid; idx < 9 * 256; idx += NWAVES * 64) { const int r = idx >> 8, col = idx & 255; float s = bmod[j0 + col];
#pragma unroll
        for (int w = 0; w < 8; ++w) s += red[(w * 9 + r) * 256 + col];
        mod[r * (NMOD * D) + j0 + col] = s; }
    __syncthreads();
}

__device__ __forceinline__ void store_modnorm(const f32x4 (&v)[4], const float* modrow, int idx, const float* gpre, bf16* arow, int lane) {
    float ss = 0.f;
#pragma unroll
    for (int j = 0; j < 4; ++j) ss += v[j].x * v[j].x + v[j].y * v[j].y + v[j].z * v[j].z + v[j].w * v[j].w;
    const float rs = rsqrtf(wave_sum(ss) * (1.f / D) + EPS);
    const float* sh = modrow + (3 * idx) * D; const float* sc = modrow + (3 * idx + 1) * D;
#pragma unroll
    for (int j = 0; j < 4; ++j) {
        const int e = 4 * (lane + 64 * j);
        const f32x4 g = *(const f32x4*)(gpre + e), s1 = *(const f32x4*)(sc + e), s0 = *(const f32x4*)(sh + e);
        f32x4 o;
        o.x = v[j].x * rs * g.x * (1.f + s1.x) + s0.x; o.y = v[j].y * rs * g.y * (1.f + s1.y) + s0.y;
        o.z = v[j].z * rs * g.z * (1.f + s1.z) + s0.z; o.w = v[j].w * rs * g.w * (1.f + s1.w) + s0.w;
        uint2 w; w.x = pk2(o.x, o.y); w.y = pk2(o.z, o.w);
        *(uint2*)(arow + e) = w;
    }
}
__device__ __forceinline__ void phase_prenorm(const Frame& F, const float* xl, const float* xc, const float* mod, int idx, const float* gpre, bf16* A, int M) {
    const int gw = F.vcu * NWAVES + F.wave, NGW = F.G * NWAVES;
    for (int row = gw; row < M; row += NGW) {
        const float* src = row < ML ? xl + (size_t)row * D : xc + (size_t)(row - ML) * D;
        const float* modrow = mod + (size_t)(row < ML ? row / T : 8) * (NMOD * D);
        f32x4 v[4];
#pragma unroll
        for (int j = 0; j < 4; ++j) v[j] = *(const f32x4*)(src + 4 * (F.lane + 64 * j));
        store_modnorm(v, modrow, idx, gpre, A + (size_t)row * D, F.lane);
    }
}
__device__ __forceinline__ void phase_resnorm(const Frame& F, const float* Fm, const float* xl, const float* xc, const float* mod, int idx, const float* gpost, float res_w,
                                              float* xout, int nidx, const float* gpre_n, bf16* A, int M) {
    const int gw = F.vcu * NWAVES + F.wave, NGW = F.G * NWAVES, lane = F.lane;
    for (int row = gw; row < M; row += NGW) {
        const float* src = row < ML ? xl + (size_t)row * D : xc + (size_t)(row - ML) * D;
        const float* modrow = mod + (size_t)(row < ML ? row / T : 8) * (NMOD * D);
        const float* gate = modrow + (3 * idx + 2) * D;
        f32x4 f[4], v[4]; float ss = 0.f;
#pragma unroll
        for (int j = 0; j < 4; ++j) { f[j] = *(const f32x4*)(Fm + (size_t)row * D + 4 * (lane + 64 * j)); ss += f[j].x * f[j].x + f[j].y * f[j].y + f[j].z * f[j].z + f[j].w * f[j].w; }
        const float rs = rsqrtf(wave_sum(ss) * (1.f / D) + EPS);
#pragma unroll
        for (int j = 0; j < 4; ++j) {
            const int e = 4 * (lane + 64 * j);
            const f32x4 xo = *(const f32x4*)(src + e), g = *(const f32x4*)(gpost + e), gt = *(const f32x4*)(gate + e);
            v[j].x = xo.x + res_w * gt.x * (f[j].x * rs * g.x); v[j].y = xo.y + res_w * gt.y * (f[j].y * rs * g.y);
            v[j].z = xo.z + res_w * gt.z * (f[j].z * rs * g.z); v[j].w = xo.w + res_w * gt.w * (f[j].w * rs * g.w);
            if (xout && row < ML) *(f32x4*)(xout + (size_t)row * D + e) = v[j];
        }
        if (nidx >= 0) store_modnorm(v, modrow, nidx, gpre_n, A + (size_t)row * D, lane);
    }
}

struct Args { const float* in[22]; float* out; unsigned char* ws; int ph_lo, ph_hi, li, pad; };
__global__ void __launch_bounds__(NWAVES * 64, 2) mega(Args args) {
    extern __shared__ __attribute__((aligned(16))) unsigned char lds[];
    Frame F;
    F.lds = (LAS unsigned char*)lds;
    F.MISC = (volatile LAS unsigned*)(F.lds + MISC_OFF);
    F.tid = threadIdx.x; F.lane = F.tid & 63; F.wave = __builtin_amdgcn_readfirstlane(F.tid >> 6);
    F.G = gridDim.x; { const int bx = blockIdx.x; F.vcu = (F.G % 8 == 0) ? (bx % 8) * (F.G / 8) + bx / 8 : bx; }
    unsigned char* ws = args.ws;
    F.ctl = (gu32*)(ws + WS_CTL);
    const float* x = args.in[0]; const float* c = args.in[1]; const float* ctx = args.in[2]; const float* cctx = args.in[3];
    const float* wmod = args.in[4]; const float* bmod = args.in[5]; const float* npre = args.in[6]; const float* npost = args.in[7];
    const float* gu1 = args.in[8]; const float* dn1 = args.in[9]; const float* gu2 = args.in[10]; const float* dn2 = args.in[11];
    const float* win = args.in[12]; const float* wout = args.in[13];
    const float* wa = args.in[16]; const float* wx = args.in[18];
    float* out = args.out;
    float* mod = (float*)(ws + WS_MOD);
    bf16* WGU1 = (bf16*)(ws + WS_WGU1); bf16* WD1 = (bf16*)(ws + WS_WD1); bf16* WGU2 = (bf16*)(ws + WS_WGU2); bf16* WD2 = (bf16*)(ws + WS_WD2);
    bf16* WIN = (bf16*)(ws + WS_WIN); bf16* WOUT = (bf16*)(ws + WS_WOUT); bf16* WG = (bf16*)(ws + WS_WG);
    bf16* A = (bf16*)(ws + WS_A); bf16* Y = A; bf16* ACT = (bf16*)(ws + WS_ACT); bf16* P = ACT; float* Fm = (float*)(ws + WS_F);

    for (int u = F.tid; u < (LDS_BYTES - LDSCTL_OFF) / 4; u += NWAVES * 64) ((LAS unsigned*)(F.lds + LDSCTL_OFF))[u] = 0u;
    __syncthreads();
    XcdBarrier bar = xcd_barrier_post((unsigned*)(F.ctl + CW_BAR) + args.li * XCD_BAR_WORDS, F.MISC + 8);
    const int lo = args.ph_lo, hi = args.ph_hi;
#define IN(k) (lo <= (k) && (k) < hi)
#define SEAM(k) do { if (IN(k) && IN((k) + 1)) xcd_barrier(bar); } while (0)

    if (IN(0)) {
        if (F.vcu < 36) p0_mod_item(F, c, cctx, wmod, bmod, mod, F.vcu);
        LAS float* scr = (LAS float*)(F.lds + RING_OFF + F.wave * 16384);
        const int gw = F.vcu * NWAVES + F.wave, NGW = F.G * NWAVES;
        constexpr int I_GU = (D / 64) * (2 * DFF / 32), I_DN = (DFF / 64) * (D / 32), I_IN = (D / 64) * (DIN / 32), I_OUT = (D / 64) * (D / 32), I_G = 32 * 2;
        constexpr int NITEMS = 2 * I_GU + 2 * I_DN + I_IN + I_OUT + I_G;
        for (int it = gw; it < NITEMS; it += NGW) {
            int r = it;
            if (r < 2 * I_GU) { const int which = r / I_GU; r -= which * I_GU; const int nblk = 2 * DFF / 32, kb = r / nblk, nb = r % nblk;
                p0_transpose_item(which ? gu2 : gu1, 2 * DFF, D, which ? WGU2 : WGU1, gu_row(32 * nb), 64 * kb, 32 * nb, scr, F.lane); continue; } r -= 2 * I_GU;
            if (r < 2 * I_DN) { const int which = r / I_DN; r -= which * I_DN; const int nblk = D / 32, kb = r / nblk, nb = r % nblk;
                p0_transpose_item(which ? dn2 : dn1, D, DFF, which ? WD2 : WD1, 32 * nb, 64 * kb, 32 * nb, scr, F.lane); continue; } r -= 2 * I_DN;
            if (r < I_IN) { const int nblk = DIN / 32, kb = r / nblk, nb = r % nblk; p0_transpose_item(win, DIN, D, WIN, 32 * nb, 64 * kb, 32 * nb, scr, F.lane); continue; } r -= I_IN;
            if (r < I_OUT) { const int nblk = D / 32, kb = r / nblk, nb = r % nblk; p0_transpose_item(wout, D, D, WOUT, 32 * nb, 64 * kb, 32 * nb, scr, F.lane); continue; } r -= I_OUT;
            { const int mtx = r >> 1, nb = r & 1, gate = mtx >> 4, dn = mtx & 15;
              p0_transpose_item((gate ? wx : wa) + (size_t)dn * 4096, 64, 64, WG + (size_t)mtx * 4096, 32 * nb, 0, 32 * nb, scr, F.lane); }
        }
    }
    SEAM(0);
    if (IN(1)) phase_prenorm(F, x, ctx, mod, 0, npre + 0 * D, A, MT);
    SEAM(1);
    if (IN(2)) { pg8::Gemm g{A, WGU1, MT, 2 * DFF, D}; pg8::StaticOrder S; S.init(MT, 2 * DFF, F.G, (int)blockIdx.x); pg8::EpiSwiGLU E{ACT, DFF};
        pg8::gemm_phase<pg8::EpiSwiGLU, pg8::StaticOrder, true, true>(F.lds + RING_OFF, g, S, E); }
    SEAM(2);
    if (IN(3)) { pg8::Gemm g{ACT, WD1, MT, D, DFF}; pg8::StaticOrder S; S.init(MT, D, F.G, (int)blockIdx.x); pg8::EpiF32 E{Fm, D};
        pg8::gemm_phase<pg8::EpiF32, pg8::StaticOrder, true, true>(F.lds + RING_OFF, g, S, E); }
    SEAM(3);
    if (IN(4)) phase_resnorm(F, Fm, x, ctx, mod, 0, npost + 0 * D, 0.5f, out, 1, npre + 1 * D, A, MT);
    SEAM(4);
    if (IN(5)) { pg8::Gemm g{A, WIN, MT, DIN, D}; pg8::StaticOrder S; S.init(MT, DIN, F.G, (int)blockIdx.x); pg8::EpiBf16 E{P, DIN};
        pg8::gemm_phase<pg8::EpiBf16, pg8::StaticOrder, true, true>(F.lds + RING_OFF, g, S, E); }
    SEAM(5);
    if (IN(8)) { pg8::Gemm g{Y, WOUT, ML, D, D}; pg8::StaticOrder S; S.init(ML, D, F.G, (int)blockIdx.x); pg8::EpiF32 E{Fm, D};
        pg8::gemm_phase<pg8::EpiF32, pg8::StaticOrder, true, true>(F.lds + RING_OFF, g, S, E); }
    SEAM(8);
    if (IN(9)) phase_resnorm(F, Fm, out, ctx, mod, 1, npost + 1 * D, 1.0f, out, 2, npre + 2 * D, A, ML);
    SEAM(9);
    if (IN(10)) { pg8::Gemm g{A, WGU2, ML, 2 * DFF, D}; pg8::StaticOrder S; S.init(ML, 2 * DFF, F.G, (int)blockIdx.x); pg8::EpiSwiGLU E{ACT, DFF};
        pg8::gemm_phase<pg8::EpiSwiGLU, pg8::StaticOrder, true, true>(F.lds + RING_OFF, g, S, E); }
    SEAM(10);
    if (IN(11)) { pg8::Gemm g{ACT, WD2, ML, D, DFF}; pg8::StaticOrder S; S.init(ML, D, F.G, (int)blockIdx.x); pg8::EpiF32 E{Fm, D};
        pg8::gemm_phase<pg8::EpiF32, pg8::StaticOrder, true, true>(F.lds + RING_OFF, g, S, E); }
    SEAM(11);
    if (IN(12)) phase_resnorm(F, Fm, out, ctx, mod, 2, npost + 2 * D, 0.5f, out, -1, nullptr, nullptr, ML);
#undef IN
#undef SEAM
}

__global__ __launch_bounds__(512) void k_gates(const bf16* P, const float* cw, const float* cb, const float* wa, const float* ba, const float* wx, const float* bx,
                                               const float* lam, int dir, float* Aa, float* Uu) {
    __shared__ float xl[DREC];
    const int R = blockIdx.x, ch = threadIdx.x;
    int t, Tlen, base;
    if (R < ML) { t = R % T; Tlen = T; base = R - t; } else { t = (R - ML) % CT; Tlen = CT; base = R - t; }
    float acc = cb[ch];
#pragma unroll
    for (int k = 0; k < 4; ++k) { const int tt = t + k - 2; if (tt >= 0 && tt < Tlen) acc += bf2f(P[(size_t)(base + tt) * DIN + ch]) * cw[k * DREC + ch]; }
    xl[ch] = acc;
    __syncthreads();
    const int n = ch >> 6, dl = ch & 63;
    const float* wap = wa + ((size_t)(dir * 8 + n) * 64) * 64 + dl; const float* wxp = wx + ((size_t)(dir * 8 + n) * 64) * 64 + dl;
    float ga = ba[dir * DREC + ch], gx = bx[dir * DREC + ch];
    for (int c = 0; c < 64; ++c) { const float xv = xl[n * 64 + c]; ga += xv * wap[c * 64]; gx += xv * wxp[c * 64]; }
    const float lm = lam[dir * DREC + ch];
    const float logsig = -log1pf(expf(-lm));
    const float log_a = 8.0f * sigmoidf_(ga) * logsig;
    const float a = expf(log_a);
    const float u = sqrtf(-expm1f(2.0f * log_a)) * sigmoidf_(gx) * acc;
    Aa[(size_t)R * DREC + ch] = a; Uu[(size_t)R * DREC + ch] = u;
}
__global__ void k_scan(const float* Aa, const float* Uu, int dir, float* Y) {
    const int ch = blockIdx.x * 64 + threadIdx.x, b = blockIdx.y;
    float h = 0.f;
    if (dir == 0) {
        for (int t = 0; t < CT; ++t) { const size_t i = (size_t)(ML + b * CT + t) * DREC + ch; h = Aa[i] * h + Uu[i]; }
        for (int t = 0; t < T; ++t) { const size_t i = (size_t)(b * T + t) * DREC + ch; h = Aa[i] * h + Uu[i]; Y[i] = h; }
    } else {
        for (int t = CT - 1; t >= 0; --t) { const size_t i = (size_t)(ML + b * CT + t) * DREC + ch; h = Aa[i] * h + Uu[i]; }
        for (int t = T - 1; t >= 0; --t) { const size_t i = (size_t)(b * T + t) * DREC + ch; h = Aa[i] * h + Uu[i]; Y[i] += h; }
    }
}
__device__ __forceinline__ float gelu_tanh(float x) { const float z = 0.7978845608028654f * (x + 0.044715f * x * x * x); return x * sigmoidf_(2.f * z); }
__global__ void k_recout(const float* Y, const bf16* P, bf16* Yout) {
    const size_t i = (size_t)blockIdx.x * 256 + threadIdx.x; const int ch = (int)(i % DREC); const size_t row = i / DREC;
    const float g = bf2f(P[row * DIN + DREC + ch]);
    Yout[row * D + ch] = (bf16)f2bf(Y[i] * gelu_tanh(g));
}
__global__ __launch_bounds__(256) void k_attn(const bf16* P, const float* rpb, bf16* Yout) {
    __shared__ float qs[4][64]; __shared__ float ps[4][384];
    const int wave = threadIdx.x >> 6, lane = threadIdx.x & 63;
    const int gq = blockIdx.x * 4 + wave;
    const int t = gq % T, h = (gq / T) % 8, b = gq / (T * 8);
    const int r = t / 64, c = t % 64;
    const int rs = min(max(r - 4, 0), 56), cs = min(max(c - 8, 0), 48);
    const size_t qrow = (size_t)(b * T + t);
    qs[wave][lane] = bf2f(P[qrow * DIN + 1024 + h * 64 + lane]);
    __syncthreads();
    float s[6]; float mx = -1e30f;
#pragma unroll
    for (int kk = 0; kk < 6; ++kk) {
        const int idx = lane + 64 * kk; size_t krow; float bias = 0.f;
        if (idx < 128) { const int kr = rs + (idx >> 4), kc = cs + (idx & 15); krow = (size_t)(b * T + kr * 64 + kc); bias = rpb[(h * 15 + (kr - r + 7)) * 31 + (kc - c + 15)]; }
        else krow = (size_t)(ML + b * CT + (idx - 128));
        const bf16* kp = P + krow * DIN + 1536 + h * 64;
        float acc = 0.f;
#pragma unroll
        for (int d8 = 0; d8 < 8; ++d8) { const uint4 kv = *(const uint4*)(kp + d8 * 8); const unsigned w[4] = {kv.x, kv.y, kv.z, kv.w};
#pragma unroll
            for (int e = 0; e < 4; ++e) { acc += qs[wave][d8 * 8 + 2 * e] * __builtin_bit_cast(float, w[e] << 16) + qs[wave][d8 * 8 + 2 * e + 1] * __builtin_bit_cast(float, w[e] & 0xffff0000u); } }
        s[kk] = acc * 0.125f + bias; mx = fmaxf(mx, s[kk]);
    }
    mx = wave_max(mx); float l = 0.f;
#pragma unroll
    for (int kk = 0; kk < 6; ++kk) { const float p = __expf(s[kk] - mx); l += p; ps[wave][lane + 64 * kk] = p; }
    l = wave_sum(l);
    __syncthreads();
    float o = 0.f;
    for (int idx = 0; idx < 384; ++idx) {
        size_t krow;
        if (idx < 128) { const int kr = rs + (idx >> 4), kc = cs + (idx & 15); krow = (size_t)(b * T + kr * 64 + kc); } else krow = (size_t)(ML + b * CT + (idx - 128));
        o += ps[wave][idx] * bf2f(P[krow * DIN + 2048 + h * 64 + lane]);
    }
    Yout[qrow * D + 512 + h * 64 + lane] = (bf16)f2bf(o / l);
}

extern "C" void kernel_launch(void* const* d_in, const int* in_sizes, int n_in, void* d_out, int out_size, void* d_ws, size_t ws_size, hipStream_t stream) {
    static int grid = 0;
    if (grid == 0) {
        if (n_in != 22 || in_sizes[0] != ML * D || out_size != ML * D || ws_size < WS_END) { fprintf(stderr, "kernel_launch: unexpected shapes (n_in %d in0 %d out %d ws %zu)\n", n_in, n_in > 0 ? in_sizes[0] : -1, out_size, ws_size); grid = -1; return; }
        int dev = 0, cus = 0;
        if (hipGetDevice(&dev) != hipSuccess || hipDeviceGetAttribute(&cus, hipDeviceAttributeMultiprocessorCount, dev) != hipSuccess) { grid = -1; return; }
        if (hipFuncSetAttribute((const void*)mega, hipFuncAttributeMaxDynamicSharedMemorySize, LDS_BYTES) != hipSuccess) { fprintf(stderr, "kernel_launch: hipFuncSetAttribute failed\n"); grid = -1; return; }
        int per_cu = 0;
        if (hipOccupancyMaxActiveBlocksPerMultiprocessor(&per_cu, (const void*)mega, NWAVES * 64, LDS_BYTES) != hipSuccess || per_cu < 1) fprintf(stderr, "kernel_launch: occupancy query reports %d\n", per_cu);
        (void)hipGetLastError();
        grid = cus;
    }
    if (grid < 0) return;
    (void)hipMemsetAsync((char*)d_ws + WS_CTL, 0, CTL_ZERO_BYTES, stream);
    Args a{};
    for (int i = 0; i < 22; ++i) a.in[i] = (const float*)d_in[i];
    a.out = (float*)d_out; a.ws = (unsigned char*)d_ws;
    char* ws = (char*)d_ws;
    bf16* P = (bf16*)(ws + WS_ACT); bf16* Y = (bf16*)(ws + WS_A); float* Aa = (float*)(ws + WS_F); float* Uu = Aa + (size_t)MT * DREC; float* YR = (float*)(ws + WS_YREC);
    const float* cw = (const float*)d_in[14]; const float* cb = (const float*)d_in[15];
    const float* wa = (const float*)d_in[16]; const float* ba = (const float*)d_in[17]; const float* wx = (const float*)d_in[18]; const float* bx = (const float*)d_in[19];
    const float* lam = (const float*)d_in[20]; const float* rpb = (const float*)d_in[21];

    a.ph_lo = 0; a.ph_hi = 6; a.li = 0;
    hipLaunchKernelGGL(mega, dim3(grid), dim3(NWAVES * 64), LDS_BYTES, stream, a);
    for (int dir = 0; dir < 2; ++dir) {
        k_gates<<<MT, 512, 0, stream>>>(P, cw, cb, wa, ba, wx, bx, lam, dir, Aa, Uu);
        k_scan<<<dim3(DREC / 64, NB), 64, 0, stream>>>(Aa, Uu, dir, YR);
    }
    k_recout<<<(size_t)ML * DREC / 256, 256, 0, stream>>>(YR, P, Y);
    k_attn<<<NB * 8 * T / 4, 256, 0, stream>>>(P, rpb, Y);
    a.ph_lo = 8; a.ph_hi = 13; a.li = 1;
    hipLaunchKernelGGL(mega, dim3(grid), dim3(NWAVES * 64), LDS_BYTES, stream, a);
}
```

```cpp
#include <hip/hip_runtime.h>
#include <stdint.h>
#include <cstdio>

namespace pg8 {
#define PG8_LAS __attribute__((address_space(3)))
typedef unsigned short bf16_t;
typedef short bf16x8 __attribute__((ext_vector_type(8)));
typedef float f32x4 __attribute__((ext_vector_type(4)));
typedef unsigned u32x4 __attribute__((ext_vector_type(4)));
constexpr int BM = 256, BK = 64, HALF = 128, HTB = HALF * BK * 2, STAGE_BYTES = 8 * HTB, NXCD = 8, WGM = 8;

__host__ __device__ __forceinline__ int lds_byte(int r, int c) { const int st = (r >> 4) * 2 + (c >> 5), rr = r & 15, cc = c & 31, ob = rr * 64 + cc * 2; return st * 1024 + (ob ^ (((ob >> 9) & 1) << 5)); }
__host__ __device__ __forceinline__ void stage_rc(int b, int& R, int& C) { const int st = b / 1024, sb = b % 1024, swz = sb ^ (((sb >> 9) & 1) << 5); R = (st >> 1) * 16 + swz / 64; C = (st & 1) * 32 + (swz % 64) / 2; }
__host__ __device__ __forceinline__ int perm32(int rho) { const int n = rho >> 4, i = rho & 15; return 8 * (i >> 2) + 4 * n + (i & 3); }

struct Unit { int pm, pn, kind; };
struct Gemm { const bf16_t* A; const bf16_t* Bt; int M, N, K; };

struct StaticOrder {
    int nM, nN, nwg, G, c;
    __host__ __device__ void init(int M, int N, int G_, int c_) { nM = M / BM; nN = N / BM; nwg = nM * nN; G = G_; c = c_; }
    __host__ __device__ bool next(int i, Unit& u) const {
        const long L = (long)i * G + c; if (L >= nwg) return false;
        int wgid = (int)L; { const int q = nwg / NXCD, r = nwg % NXCD, xcd = wgid % NXCD, off = wgid / NXCD; wgid = (xcd < r ? xcd * (q + 1) : r * (q + 1) + (xcd - r) * q) + off; }
        const int nig = WGM * nN, gid = wgid / nig, fm = gid * WGM, gsz = (nM - fm) < WGM ? (nM - fm) : WGM;
        u.pm = fm + ((wgid % nig) % gsz); u.pn = (wgid % nig) / gsz; u.kind = 0; return true;
    }
    __device__ __forceinline__ void operands(const Gemm& g, const Unit& u, const char*& a, const char*& b) const {
        a = (const char*)g.A + (size_t)u.pm * (size_t)BM * g.K * 2; b = (const char*)g.Bt + (size_t)u.pn * (size_t)BM * g.K * 2; }
    __device__ __forceinline__ void a_ready(const Unit&) const {}
    __device__ __forceinline__ void done(const Unit&) const {}
};

__device__ __forceinline__ unsigned cvt_pk_bf16(float lo, float hi) { unsigned r; asm volatile("v_cvt_pk_bf16_f32 %0, %1, %2" : "=v"(r) : "v"(lo), "v"(hi)); return r; }

struct EpiF32 {
    static constexpr bool PERM = false, AFTER_DRAIN = false;
    float* C; int ldc;
    __device__ __forceinline__ void operator()(const f32x4 (&acc)[2][2][4][2], const Unit& u, int wr, int wc, int fr, int fq) const {
        const int row0 = u.pm * BM + wr * 64 + fr, col0 = u.pn * BM + wc * 32 + 4 * fq;
#pragma unroll
        for (int ai = 0; ai < 2; ++ai)
#pragma unroll
            for (int m = 0; m < 4; ++m) { float* rowp = C + (size_t)(row0 + ai * HALF + m * 16) * ldc + col0;
#pragma unroll
                for (int bj = 0; bj < 2; ++bj)
#pragma unroll
                    for (int n = 0; n < 2; ++n) *(f32x4*)(rowp + bj * HALF + n * 16) = acc[ai][bj][m][n]; }
    }
};
struct EpiBf16 {
    static constexpr bool PERM = true, AFTER_DRAIN = false;
    bf16_t* O; int ldc;
    __device__ __forceinline__ void operator()(const f32x4 (&acc)[2][2][4][2], const Unit& u, int wr, int wc, int fr, int fq) const {
        const int row0 = u.pm * BM + wr * 64 + fr, col0 = u.pn * BM + wc * 32 + 8 * fq;
#pragma unroll
        for (int ai = 0; ai < 2; ++ai)
#pragma unroll
            for (int m = 0; m < 4; ++m) { bf16_t* rowp = O + (size_t)(row0 + ai * HALF + m * 16) * ldc + col0;
#pragma unroll
                for (int bj = 0; bj < 2; ++bj) { const f32x4 v0 = acc[ai][bj][m][0], v1 = acc[ai][bj][m][1];
                    u32x4 w; w.x = cvt_pk_bf16(v0[0], v0[1]); w.y = cvt_pk_bf16(v0[2], v0[3]); w.z = cvt_pk_bf16(v1[0], v1[1]); w.w = cvt_pk_bf16(v1[2], v1[3]);
                    *(u32x4*)(rowp + bj * HALF) = w; } }
    }
};
__device__ __forceinline__ float silu_mul(float g, float u) { return g * u * __builtin_amdgcn_rcpf(1.f + __builtin_amdgcn_exp2f(-1.4426950408889634f * g)); }
struct EpiSwiGLU {
    static constexpr bool PERM = true, AFTER_DRAIN = false;
    bf16_t* O; int ldc;
    __device__ __forceinline__ void operator()(const f32x4 (&acc)[2][2][4][2], const Unit& u, int wr, int wc, int fr, int fq) const {
        const int row0 = u.pm * BM + wr * 64 + fr, col0 = u.pn * HALF + wc * 32 + 8 * fq;
#pragma unroll
        for (int ai = 0; ai < 2; ++ai)
#pragma unroll
            for (int m = 0; m < 4; ++m) { bf16_t* rowp = O + (size_t)(row0 + ai * HALF + m * 16) * ldc + col0;
                const f32x4 g0 = acc[ai][0][m][0], g1 = acc[ai][0][m][1], u0 = acc[ai][1][m][0], u1 = acc[ai][1][m][1];
                u32x4 w; w.x = cvt_pk_bf16(silu_mul(g0[0], u0[0]), silu_mul(g0[1], u0[1])); w.y = cvt_pk_bf16(silu_mul(g0[2], u0[2]), silu_mul(g0[3], u0[3]));
                w.z = cvt_pk_bf16(silu_mul(g1[0], u1[0]), silu_mul(g1[1], u1[1])); w.w = cvt_pk_bf16(silu_mul(g1[2], u1[2]), silu_mul(g1[3], u1[3]));
                *(u32x4*)rowp = w; }
    }
};


struct InprojOrder {
    int G, c;
    static constexpr int NW = 1328;
    __device__ __forceinline__ bool next(int i, Unit& u) const {
        const long L = (long)i * G + c; if (L >= NW) return false;
        const int wgid = (int)(L % NXCD) * (NW / NXCD) + (int)(L / NXCD);
        if (wgid < 1024) { const int gid = wgid >> 6, w = wgid & 63; u.pm = gid * 8 + (w & 7); u.pn = w >> 3; u.kind = 0; }
        else if (wgid < 1056) { const int l = wgid - 1024, q = l >> 3; u.pm = 128 + (l & 7); u.pn = q < 2 ? q : q + 4; u.kind = 0; }
        else { const int l = wgid - 1056; u.pm = l & 1; u.pn = l >> 1; u.kind = 1; }
        return true;
    }
    __device__ __forceinline__ void operands(const Gemm& g, const Unit& u, const char*& a, const char*& b) const {
        const size_t ts = (size_t)BM * g.K * 2;
        if (u.kind == 0) { a = (const char*)g.A + (size_t)u.pm * ts; b = (const char*)g.Bt + (size_t)u.pn * ts; }
        else { a = (const char*)g.Bt + (size_t)(8 + u.pm) * ts; b = (const char*)g.A + (size_t)u.pn * ts; }
    }
    __device__ __forceinline__ void a_ready(const Unit&) const {}
    __device__ __forceinline__ void done(const Unit&) const {}
};
__device__ __forceinline__ float gelu_tanh_e(float x) { const float z = 0.7978845608028654f * (x + 0.044715f * x * x * x); return x * __builtin_amdgcn_rcpf(1.f + __builtin_amdgcn_exp2f(-2.8853900817779268f * z)); }
struct EpiInproj {
    static constexpr bool PERM = true, AFTER_DRAIN = false;
    bf16_t* Pout; bf16_t* VT; int ldp, ldv; float qscale;
    __device__ __forceinline__ void operator()(const f32x4 (&acc)[2][2][4][2], const Unit& u, int wr, int wc, int fr, int fq) const {
        const int op = (u.kind == 0) ? ((u.pn == 2 || u.pn == 3) ? 1 : ((u.pn == 4 || u.pn == 5) ? 2 : 0)) : 0;
        bf16_t* base = u.kind == 0 ? Pout : VT; const int ldc = u.kind == 0 ? ldp : ldv;
        const float sc = op == 2 ? qscale : 1.f;
        const int row0 = u.pm * BM + wr * 64 + fr, col0 = u.pn * BM + wc * 32 + 8 * fq;
#pragma unroll
        for (int ai = 0; ai < 2; ++ai)
#pragma unroll
            for (int m = 0; m < 4; ++m) { bf16_t* rowp = base + (size_t)(row0 + ai * HALF + m * 16) * ldc + col0;
#pragma unroll
                for (int bj = 0; bj < 2; ++bj) { f32x4 v0 = acc[ai][bj][m][0], v1 = acc[ai][bj][m][1];
                    if (op == 1) { v0[0] = gelu_tanh_e(v0[0]); v0[1] = gelu_tanh_e(v0[1]); v0[2] = gelu_tanh_e(v0[2]); v0[3] = gelu_tanh_e(v0[3]);
                                   v1[0] = gelu_tanh_e(v1[0]); v1[1] = gelu_tanh_e(v1[1]); v1[2] = gelu_tanh_e(v1[2]); v1[3] = gelu_tanh_e(v1[3]); }
                    v0 = v0 * sc; v1 = v1 * sc;
                    u32x4 w; w.x = cvt_pk_bf16(v0[0], v0[1]); w.y = cvt_pk_bf16(v0[2], v0[3]); w.z = cvt_pk_bf16(v1[0], v1[1]); w.w = cvt_pk_bf16(v1[2], v1[3]);
                    *(u32x4*)(rowp + bj * HALF) = w; } }
    }
};

template <class Epi, class Sched, bool ALIGN_EPI = false, bool SP2 = false>
__device__ __forceinline__ void gemm_phase(PG8_LAS unsigned char* lds, const Gemm g, const Sched& S, const Epi& E) {
    const int tid = threadIdx.x, wid = __builtin_amdgcn_readfirstlane(tid >> 6), lane = tid & 63, wr = wid >> 2, wc = wid & 3, fr = lane & 15, fq = lane >> 4;
    const int K = g.K, nt = K / BK;
    unsigned voffA[2], voffB[2];
#pragma unroll
    for (int i = 0; i < 2; ++i) { int R, C; stage_rc(tid * 16 + i * 8192, R, C); const int Rb = Epi::PERM ? ((R & ~31) + perm32(R & 31)) : R;
        voffA[i] = (unsigned)(R * K + C) * 2u; voffB[i] = (unsigned)(Rb * K + C) * 2u; }
    const size_t kstep = (size_t)(BK * 2);
    const size_t hstep = (size_t)HALF * K * 2;
    const unsigned ldsw = (unsigned)wid * 1024u;
    const int aoff = lds_byte(wr * 64 + fr, fq * 8), boff = lds_byte(wc * 32 + fr, fq * 8);
#define PG8_SA(b, h) (((b) * 2 + (h)) * HTB)
#define PG8_SB(b, h) ((4 + (b) * 2 + (h)) * HTB)
#define PG8_STAGE(bufoff, gbase, voff) do { _Pragma("unroll") for (int _i = 0; _i < 2; ++_i) \
        __builtin_amdgcn_global_load_lds((const unsigned*)((const char*)(gbase) + (voff)[_i]), (PG8_LAS unsigned*)(lds + (bufoff) + ldsw + _i * 8192), 16, 0, 0); } while (0)
#define PG8_LDA(dst, b, h) do { _Pragma("unroll") for (int m = 0; m < 4; ++m) _Pragma("unroll") for (int k = 0; k < 2; ++k) dst[m][k] = *(const PG8_LAS bf16x8*)(lds + PG8_SA(b, h) + aoff + m * 2048 + k * 1024); } while (0)
#define PG8_LDB(dst, b, h) do { _Pragma("unroll") for (int n = 0; n < 2; ++n) _Pragma("unroll") for (int k = 0; k < 2; ++k) dst[n][k] = *(const PG8_LAS bf16x8*)(lds + PG8_SB(b, h) + boff + n * 2048 + k * 1024); } while (0)
#define PG8_MMA(ai, bj, At, Bt) do { __builtin_amdgcn_s_setprio(1); _Pragma("unroll") for (int m = 0; m < 4; ++m) _Pragma("unroll") for (int n = 0; n < 2; ++n) _Pragma("unroll") for (int k = 0; k < 2; ++k) \
        acc[ai][bj][m][n] = __builtin_amdgcn_mfma_f32_16x16x32_bf16(Bt[n][k], At[m][k], acc[ai][bj][m][n], 0, 0, 0); __builtin_amdgcn_s_setprio(0); } while (0)
#define PG8_WAIT_V(n) asm volatile("s_waitcnt vmcnt(" #n ")" ::: "memory")
#define PG8_WAIT_L(n) asm volatile("s_waitcnt lgkmcnt(" #n ")" ::: "memory")
#define PG8_BAR __builtin_amdgcn_s_barrier()
#define PG8_SCHED __builtin_amdgcn_sched_barrier(0)
    Unit cur, nxt; int ui = 0;
    if (!S.next(0, cur)) return;
    f32x4 acc[2][2][4][2];
#pragma unroll
    for (int a = 0; a < 2; ++a)
#pragma unroll
        for (int b = 0; b < 2; ++b)
#pragma unroll
            for (int m = 0; m < 4; ++m)
#pragma unroll
                for (int n = 0; n < 2; ++n) acc[a][b][m][n] = (f32x4){0.f, 0.f, 0.f, 0.f};
    bf16x8 At[4][2], B0[2][2], B1[2][2];
    const char* cA; const char* cB; S.operands(g, cur, cA, cB);
    S.a_ready(cur);
    if constexpr (SP2) {
        PG8_STAGE(PG8_SB(0, 0), cB, voffB); PG8_STAGE(PG8_SB(0, 1), cB + hstep, voffB); PG8_STAGE(PG8_SA(0, 0), cA, voffA); PG8_STAGE(PG8_SA(0, 1), cA + hstep, voffA);
        if (wr == 1) PG8_BAR;
        PG8_WAIT_V(2); PG8_BAR;
        PG8_STAGE(PG8_SB(1, 0), cB + kstep, voffB); PG8_STAGE(PG8_SA(1, 0), cA + kstep, voffA); PG8_STAGE(PG8_SB(1, 1), cB + hstep + kstep, voffB);
        PG8_WAIT_V(6); PG8_BAR;
    } else {
        PG8_STAGE(PG8_SB(0, 0), cB, voffB); PG8_STAGE(PG8_SA(0, 0), cA, voffA); PG8_STAGE(PG8_SB(0, 1), cB + hstep, voffB); PG8_STAGE(PG8_SA(0, 1), cA + hstep, voffA);
        if (wr == 1) PG8_BAR;
        PG8_WAIT_V(4); PG8_BAR;
        PG8_STAGE(PG8_SB(1, 0), cB + kstep, voffB); PG8_STAGE(PG8_SA(1, 0), cA + kstep, voffA); PG8_STAGE(PG8_SB(1, 1), cB + hstep + kstep, voffB);
        PG8_WAIT_V(6); PG8_BAR;
    }
    for (;;) {
        const bool has_next = S.next(ui + 1, nxt);
        const char* nA = cA; const char* nB = cB; if (has_next) S.operands(g, nxt, nA, nB);
        for (int t = 0; t < nt; t += 2) {
            const bool last = (t == nt - 2);
            const char* a1 = cA + (size_t)(t + 1) * kstep;
            const char* a2 = last ? nA : cA + (size_t)(t + 2) * kstep; const char* b2 = last ? nB : cB + (size_t)(t + 2) * kstep;
            const char* a3 = a2 + kstep; const char* b3 = b2 + kstep;
            if (last && has_next) S.a_ready(nxt);
            if constexpr (SP2) {
            PG8_LDB(B0, 0, 0); PG8_LDB(B1, 0, 1); PG8_SCHED; PG8_LDA(At, 0, 0); PG8_STAGE(PG8_SA(1, 1), a1 + hstep, voffA);
            PG8_WAIT_V(8); PG8_WAIT_L(0); PG8_BAR; PG8_MMA(0, 0, At, B0); PG8_MMA(0, 1, At, B1); PG8_BAR; PG8_SCHED;
            PG8_LDA(At, 0, 1); PG8_STAGE(PG8_SB(0, 0), b2, voffB); PG8_STAGE(PG8_SB(0, 1), b2 + hstep, voffB); PG8_STAGE(PG8_SA(0, 0), a2, voffA);
            PG8_WAIT_V(8); PG8_WAIT_L(0); PG8_BAR; PG8_MMA(1, 0, At, B0); PG8_MMA(1, 1, At, B1); PG8_BAR; PG8_SCHED;
            PG8_LDB(B0, 1, 0); PG8_LDB(B1, 1, 1); PG8_SCHED; PG8_LDA(At, 1, 0); PG8_STAGE(PG8_SA(0, 1), a2 + hstep, voffA);
            PG8_WAIT_V(8); PG8_WAIT_L(0); PG8_BAR; PG8_MMA(0, 0, At, B0); PG8_MMA(0, 1, At, B1); PG8_BAR; PG8_SCHED;
            PG8_LDA(At, 1, 1); PG8_STAGE(PG8_SB(1, 0), b3, voffB); PG8_STAGE(PG8_SB(1, 1), b3 + hstep, voffB); PG8_STAGE(PG8_SA(1, 0), a3, voffA);
            PG8_WAIT_V(8); PG8_WAIT_L(0); PG8_BAR; PG8_MMA(1, 0, At, B0); PG8_MMA(1, 1, At, B1); PG8_BAR; PG8_SCHED;
            } else {
            PG8_LDB(B0, 0, 0); PG8_SCHED; PG8_LDA(At, 0, 0); PG8_STAGE(PG8_SA(1, 1), a1 + hstep, voffA);
            PG8_WAIT_L(8); PG8_BAR; PG8_WAIT_L(0); PG8_MMA(0, 0, At, B0); PG8_BAR; PG8_SCHED;
            PG8_LDB(B1, 0, 1); PG8_STAGE(PG8_SB(0, 0), b2, voffB);
            PG8_BAR; PG8_WAIT_L(0); PG8_MMA(0, 1, At, B1); PG8_BAR;
            PG8_LDA(At, 0, 1); PG8_STAGE(PG8_SA(0, 0), a2, voffA);
            PG8_BAR; PG8_WAIT_L(0); PG8_MMA(1, 0, At, B0); PG8_BAR; PG8_SCHED;
            PG8_STAGE(PG8_SB(0, 1), b2 + hstep, voffB);
            PG8_WAIT_V(6); PG8_BAR; PG8_MMA(1, 1, At, B1); PG8_BAR;
            PG8_LDB(B0, 1, 0); PG8_SCHED; PG8_LDA(At, 1, 0); PG8_STAGE(PG8_SA(0, 1), a2 + hstep, voffA);
            PG8_WAIT_L(8); PG8_BAR; PG8_WAIT_L(0); PG8_MMA(0, 0, At, B0); PG8_BAR; PG8_SCHED;
            PG8_LDB(B1, 1, 1); PG8_STAGE(PG8_SB(1, 0), b3, voffB);
            PG8_BAR; PG8_WAIT_L(0); PG8_MMA(0, 1, At, B1); PG8_BAR;
            PG8_LDA(At, 1, 1); PG8_STAGE(PG8_SA(1, 0), a3, voffA);
            PG8_BAR; PG8_WAIT_L(0); PG8_MMA(1, 0, At, B0); PG8_BAR; PG8_SCHED;
            PG8_STAGE(PG8_SB(1, 1), b3 + hstep, voffB);
            PG8_WAIT_V(6); PG8_BAR; PG8_MMA(1, 1, At, B1); PG8_BAR;
            }
        }
        if constexpr (ALIGN_EPI) { if (wr == 0) PG8_BAR; }
        if constexpr (!Epi::AFTER_DRAIN) { E(acc, cur, wr, wc, fr, fq); S.done(cur); }
        if (!has_next) break;
#pragma unroll
        for (int a = 0; a < 2; ++a)
#pragma unroll
            for (int b = 0; b < 2; ++b)
#pragma unroll
                for (int m = 0; m < 4; ++m)
#pragma unroll
                    for (int n = 0; n < 2; ++n) acc[a][b][m][n] = (f32x4){0.f, 0.f, 0.f, 0.f};
        cur = nxt; cA = nA; cB = nB; ++ui;
        if constexpr (ALIGN_EPI) { if (wr == 1) PG8_BAR; }
    }
    PG8_WAIT_V(0);
    if constexpr (!ALIGN_EPI) { if (wr == 0) PG8_BAR; }
    PG8_BAR;
    if constexpr (Epi::AFTER_DRAIN) { E.fused(acc, cur, wr, wc, fr, fq, lds, wid, lane); S.done(cur); }
#undef PG8_SA
#undef PG8_SB
#undef PG8_STAGE
#undef PG8_LDA
#undef PG8_LDB
#undef PG8_MMA
#undef PG8_WAIT_V
#undef PG8_WAIT_L
#undef PG8_BAR
#undef PG8_SCHED
}
}

constexpr int NWAVES = 8;
constexpr int NB = 8, T = 4096, D = 1024, CT = 256, DFF = 2816, DIN = 2560, DREC = 512, NMOD = 9;
constexpr int ML = NB * T, MC = NB * CT, MT = ML + MC;
constexpr float EPS = 1e-6f;
constexpr size_t MiB = 1u << 20;
constexpr size_t WS_CTL = 0, CTL_ZERO_BYTES = 1 * MiB;
constexpr size_t WS_MOD = 1 * MiB;
constexpr size_t WS_WGU1 = 2 * MiB, WS_WD1 = 13 * MiB, WS_WGU2 = 19 * MiB, WS_WD2 = 30 * MiB, WS_WIN = 36 * MiB, WS_WOUT = 41 * MiB, WS_WG = 43 * MiB;
constexpr size_t WS_AGG = 44 * MiB;
constexpr size_t WS_CARRY = 49 * MiB;
constexpr size_t WS_A = 52 * MiB;
constexpr size_t WS_ACT = 120 * MiB;
constexpr size_t WS_F = 307 * MiB;
constexpr size_t WS_VT = 443 * MiB;
constexpr size_t WS_END = 512 * MiB;
constexpr int CW_TMO = 0, CW_CODE = 1, CW_BAR = 4096;

constexpr int RING_OFF = 0, RING_BYTES = 131072;
constexpr int LDSCTL_OFF = RING_BYTES, MISC_OFF = LDSCTL_OFF + 320;
constexpr int LDS_BYTES = 163840;

#define GAS __attribute__((address_space(1)))
#define LAS __attribute__((address_space(3)))
typedef unsigned short bf16;
typedef unsigned v4u __attribute__((ext_vector_type(4)));
typedef float f32x4 __attribute__((ext_vector_type(4)));
typedef short bf16x8 __attribute__((ext_vector_type(8)));
typedef GAS unsigned gu32;
#define RLX_AGENT __ATOMIC_RELAXED, __HIP_MEMORY_SCOPE_AGENT
#define LDS_WAIT() asm volatile("s_waitcnt lgkmcnt(0)" ::: "memory")
#define VM_WAIT() asm volatile("s_waitcnt vmcnt(0)" ::: "memory")
__device__ __forceinline__ unsigned f2bf(float f) { unsigned u = __builtin_bit_cast(unsigned, f); return (u + 0x7fffu + ((u >> 16) & 1u)) >> 16; }
__device__ __forceinline__ unsigned pk2(float lo, float hi) { return f2bf(lo) | (f2bf(hi) << 16); }
__device__ __forceinline__ float bf2f(unsigned short h) { return __builtin_bit_cast(float, (unsigned)h << 16); }
__device__ __forceinline__ float sigmoidf_(float x) { return 1.f / (1.f + __expf(-x)); }
__device__ __forceinline__ float wave_sum(float v) {
#pragma unroll
    for (int o = 1; o < 64; o <<= 1) v += __shfl_xor(v, o);
    return v;
}
__device__ __forceinline__ float wave_max(float v) {
#pragma unroll
    for (int o = 1; o < 64; o <<= 1) v = fmaxf(v, __shfl_xor(v, o));
    return v;
}

#define XB_TMO      128
#define XB_XCNT(j)  (256  + 64 * (j))
#define XB_XSUB(j)  (1280 + 64 * (j))
#define XB_XGEN(j)  (2304 + 64 * (j))
#define XB_TOP      3328
#define XB_TOPGEN   3392
#define XCD_BAR_WORDS 3456
#define XB_SPIN_CAP (1u << 18)

__device__ __forceinline__ unsigned xb_ld(unsigned* p)              { return __hip_atomic_load(p, __ATOMIC_RELAXED, __HIP_MEMORY_SCOPE_AGENT); }
__device__ __forceinline__ unsigned xb_add(unsigned* p, unsigned v) { return __hip_atomic_fetch_add(p, v, __ATOMIC_RELAXED, __HIP_MEMORY_SCOPE_AGENT); }
__device__ __forceinline__ unsigned xb_xcc_id() { return (unsigned)__builtin_amdgcn_s_getreg((3 << 11) | 20) & 0xFu; }
#define XB_SPIN(cond, bar) do { unsigned _sp = 0; while (cond) { __builtin_amdgcn_s_sleep(1); \
    if ((++_sp & 255u) == 0u) { if (xb_ld(&(bar)[XB_TMO])) break; if (_sp > XB_SPIN_CAP) { atomicAdd(&(bar)[XB_TMO], 1u); break; } } } } while (0)

struct XcdBarrier {
    unsigned* bar; unsigned x;
    volatile LAS unsigned* st;
};

__device__ __forceinline__ XcdBarrier xcd_barrier_post(unsigned* bar, volatile LAS unsigned* st) {
    XcdBarrier b; b.bar = bar; b.x = xb_xcc_id(); b.st = st;
    if (threadIdx.x == 0) (void)xb_add(&bar[XB_XCNT(b.x)], 1u);
    return b;
}
__device__ __forceinline__ void xcd_barrier_complete(unsigned* bar, unsigned x, unsigned& nloc, unsigned& nx) {
    const unsigned G = gridDim.x * gridDim.y * gridDim.z;
    unsigned sum, cnt, mine, sp = 0u;
    for (;;) {
        sum = 0u; cnt = 0u; mine = 0u;
#pragma unroll
        for (unsigned j = 0; j < 16; ++j) { const unsigned c = xb_ld(&bar[XB_XCNT(j)]); sum += c; cnt += (c > 0u) ? 1u : 0u; mine = (j == x) ? c : mine; }
        if (sum == G) break;
        __builtin_amdgcn_s_sleep(1);
        if ((++sp & 255u) == 0u) { if (xb_ld(&bar[XB_TMO])) break; if (sp > XB_SPIN_CAP) { atomicAdd(&bar[XB_TMO], 1u); break; } }
    }
    nloc = mine > 0u ? mine : 1u; nx = cnt > 0u ? cnt : 1u;
}

__device__ __forceinline__ void xcd_barrier(const XcdBarrier& b) {
    asm volatile("s_waitcnt vmcnt(0)" ::: "memory");
    __syncthreads();
    if (threadIdx.x == 0) {
        unsigned* bar = b.bar;
        __builtin_amdgcn_s_waitcnt(0);
        unsigned nloc = b.st[0], nx = b.st[1];
        if (nloc == 0u) { xcd_barrier_complete(bar, b.x, nloc, nx); b.st[0] = nloc; b.st[1] = nx; }
        const unsigned old = xb_add(&bar[XB_XSUB(b.x)], 1u);
        const unsigned gen = old / nloc;
        if (old + 1u == (gen + 1u) * nloc) {
            __builtin_amdgcn_fence(__ATOMIC_RELEASE, "agent");
            asm volatile("s_waitcnt vmcnt(0)" ::: "memory");
            const unsigned og = xb_add(&bar[XB_TOP], 1u);
            const unsigned tg = og / nx;
            if (og + 1u == (tg + 1u) * nx) xb_add(&bar[XB_TOPGEN], 1u);
            else XB_SPIN(xb_ld(&bar[XB_TOPGEN]) == tg, bar);
            __builtin_amdgcn_fence(__ATOMIC_ACQUIRE, "agent");
            xb_add(&bar[XB_XGEN(b.x)], 1u);
            asm volatile("s_waitcnt vmcnt(0)" ::: "memory");
        } else {
            XB_SPIN(xb_ld(&bar[XB_XGEN(b.x)]) == gen, bar);
            __builtin_amdgcn_fence(__ATOMIC_ACQUIRE, "agent");
            asm volatile("s_waitcnt vmcnt(0)" ::: "memory");
        }
    }
    __syncthreads();
}

struct Frame {
    LAS unsigned char* lds;
    volatile LAS unsigned* MISC;
    gu32* ctl;
    int tid, lane, wave;
    int vcu, G;
};

__device__ __forceinline__ void p0_transpose_item(const float* W, int ldw, int K, bf16* WT, int drow0, int k0, int n0, LAS float* scr, int lane) {
#pragma unroll 8
    for (int i = 0; i < 32; ++i) { const int kk = 2 * i + (lane >> 5); scr[kk * 33 + (lane & 31)] = W[(size_t)(k0 + kk) * ldw + n0 + (lane & 31)]; }
    LDS_WAIT(); asm volatile("" ::: "memory");
    const int c = lane & 7;
#pragma unroll
    for (int j = 0; j < 4; ++j) { const int n = (lane >> 3) + 8 * j; const LAS float* s = scr + (8 * c) * 33 + n;
        v4u o; o.x = pk2(s[0 * 33], s[1 * 33]); o.y = pk2(s[2 * 33], s[3 * 33]); o.z = pk2(s[4 * 33], s[5 * 33]); o.w = pk2(s[6 * 33], s[7 * 33]);
        *(GAS v4u*)(WT + (size_t)(drow0 + n) * K + k0 + 8 * c) = o; }
    LDS_WAIT(); asm volatile("" ::: "memory");
}
__device__ __forceinline__ int gu_row(int n0) { const int u = n0 >= DFF ? 1 : 0, j = n0 - u * DFF; return 256 * (j >> 7) + 128 * u + (j & 127); }
__device__ __forceinline__ void p0_mod_item(const Frame& F, const float* c, const float* cctx, const float* wmod, const float* bmod, float* mod, int item) {
    LAS float* sl = (LAS float*)(F.lds + RING_OFF);
    LAS float* red = (LAS float*)(F.lds + RING_OFF + 49152);
    for (int i = F.tid; i < 9 * D; i += NWAVES * 64) { const int r = i >> 10, k = i & 1023; const float v = r < 8 ? c[r * D + k] : cctx[k]; sl[k * 12 + r] = v * sigmoidf_(v); }
    __syncthreads();
    const int j0 = item * 256;
    f32x4 acc[9];
#pragma unroll
    for (int r = 0; r < 9; ++r) acc[r] = (f32x4){0.f, 0.f, 0.f, 0.f};
    const float* wp = wmod + (size_t)(128 * F.wave) * (NMOD * D) + j0 + 4 * F.lane;
#pragma unroll 4
    for (int k = 0; k < 128; ++k) {
        const f32x4 w4 = *(const f32x4*)(wp + (size_t)k * (NMOD * D));
        const LAS f32x4* sp = (const LAS f32x4*)(sl + (128 * F.wave + k) * 12);
        const f32x4 s0 = sp[0], s1 = sp[1], s2 = sp[2];
        acc[0] += w4 * s0[0]; acc[1] += w4 * s0[1]; acc[2] += w4 * s0[2]; acc[3] += w4 * s0[3];
        acc[4] += w4 * s1[0]; acc[5] += w4 * s1[1]; acc[6] += w4 * s1[2]; acc[7] += w4 * s1[3];
        acc[8] += w4 * s2[0];
    }
#pragma unroll
    for (int r = 0; r < 9; ++r) *(LAS f32x4*)(red + (F.wave * 9 + r) * 256 + 4 * F.lane) = acc[r];
    __syncthreads();
    for (int idx = F.tid; idx < 9 * 256; idx += NWAVES * 64) { const int r = idx >> 8, col = idx & 255; float s = bmod[j0 + col];
#pragma unroll
        for (int w = 0; w < 8; ++w) s += red[(w * 9 + r) * 256 + col];
        mod[r * (NMOD * D) + j0 + col] = s; }
    __syncthreads();
}

__device__ __forceinline__ void store_modnorm(const f32x4 (&v)[4], const float* modrow, int idx, const float* gpre, bf16* arow, int lane) {
    float ss = 0.f;
#pragma unroll
    for (int j = 0; j < 4; ++j) ss += v[j].x * v[j].x + v[j].y * v[j].y + v[j].z * v[j].z + v[j].w * v[j].w;
    const float rs = rsqrtf(wave_sum(ss) * (1.f / D) + EPS);
    const float* sh = modrow + (3 * idx) * D; const float* sc = modrow + (3 * idx + 1) * D;
#pragma unroll
    for (int j = 0; j < 4; ++j) {
        const int e = 4 * (lane + 64 * j);
        const f32x4 g = *(const f32x4*)(gpre + e), s1 = *(const f32x4*)(sc + e), s0 = *(const f32x4*)(sh + e);
        f32x4 o;
        o.x = v[j].x * rs * g.x * (1.f + s1.x) + s0.x; o.y = v[j].y * rs * g.y * (1.f + s1.y) + s0.y;
        o.z = v[j].z * rs * g.z * (1.f + s1.z) + s0.z; o.w = v[j].w * rs * g.w * (1.f + s1.w) + s0.w;
        uint2 w; w.x = pk2(o.x, o.y); w.y = pk2(o.z, o.w);
        *(uint2*)(arow + e) = w;
    }
}
__device__ __forceinline__ void phase_prenorm(const Frame& F, const float* xl, const float* xc, const float* mod, int idx, const float* gpre, bf16* A, int M) {
    const int gw = F.vcu * NWAVES + F.wave, NGW = F.G * NWAVES;
    for (int row = gw; row < M; row += NGW) {
        const float* src = row < ML ? xl + (size_t)row * D : xc + (size_t)(row - ML) * D;
        const float* modrow = mod + (size_t)(row < ML ? row / T : 8) * (NMOD * D);
        f32x4 v[4];
#pragma unroll
        for (int j = 0; j < 4; ++j) v[j] = *(const f32x4*)(src + 4 * (F.lane + 64 * j));
        store_modnorm(v, modrow, idx, gpre, A + (size_t)row * D, F.lane);
    }
}
__device__ __forceinline__ void phase_resnorm(const Frame& F, const float* Fm, const float* xl, const float* xc, const float* mod, int idx, const float* gpost, float res_w,
                                              float* xout, int nidx, const float* gpre_n, bf16* A, int M) {
    const int gw = F.vcu * NWAVES + F.wave, NGW = F.G * NWAVES, lane = F.lane;
    for (int row = gw; row < M; row += NGW) {
        const float* src = row < ML ? xl + (size_t)row * D : xc + (size_t)(row - ML) * D;
        const float* modrow = mod + (size_t)(row < ML ? row / T : 8) * (NMOD * D);
        const float* gate = modrow + (3 * idx + 2) * D;
        f32x4 f[4], v[4]; float ss = 0.f;
#pragma unroll
        for (int j = 0; j < 4; ++j) { f[j] = *(const f32x4*)(Fm + (size_t)row * D + 4 * (lane + 64 * j)); ss += f[j].x * f[j].x + f[j].y * f[j].y + f[j].z * f[j].z + f[j].w * f[j].w; }
        const float rs = rsqrtf(wave_sum(ss) * (1.f / D) + EPS);
#pragma unroll
        for (int j = 0; j < 4; ++j) {
            const int e = 4 * (lane + 64 * j);
            const f32x4 xo = *(const f32x4*)(src + e), g = *(const f32x4*)(gpost + e), gt = *(const f32x4*)(gate + e);
            v[j].x = xo.x + res_w * gt.x * (f[j].x * rs * g.x); v[j].y = xo.y + res_w * gt.y * (f[j].y * rs * g.y);
            v[j].z = xo.z + res_w * gt.z * (f[j].z * rs * g.z); v[j].w = xo.w + res_w * gt.w * (f[j].w * rs * g.w);
            if (xout && row < ML) *(f32x4*)(xout + (size_t)row * D + e) = v[j];
        }
        if (nidx >= 0) store_modnorm(v, modrow, nidx, gpre_n, A + (size_t)row * D, lane);
    }
}

typedef float f32x16 __attribute__((ext_vector_type(16)));
typedef float f32x2v __attribute__((ext_vector_type(2)));
typedef __bf16 bf16x2v __attribute__((ext_vector_type(2)));
constexpr float LOG2E = 1.4426950408889634f;
constexpr float QSCALE = 0.125f * LOG2E;
constexpr int RPB_OFF = RING_BYTES + 1024;
constexpr int ML_OFF = RING_BYTES + 16384;
constexpr int FAC_OFF = ML_OFF + 4096;
constexpr int NCH = 68;

__device__ __forceinline__ unsigned cvtpk(float lo, float hi) { f32x2v v = {lo, hi}; bf16x2v b = __builtin_convertvector(v, bf16x2v); return __builtin_bit_cast(unsigned, b); }
__device__ __forceinline__ bf16x8 pack8(const float* v) { v4u w; w.x = cvtpk(v[0], v[1]); w.y = cvtpk(v[2], v[3]); w.z = cvtpk(v[4], v[5]); w.w = cvtpk(v[6], v[7]); return __builtin_bit_cast(bf16x8, w); }
__device__ __forceinline__ float lo16(unsigned w) { return __builtin_bit_cast(float, w << 16); }
__device__ __forceinline__ float hi16(unsigned w) { return __builtin_bit_cast(float, w & 0xffff0000u); }
__device__ __forceinline__ int rowperm32(int i) { return 16 * ((i >> 2) & 1) + (i & 3) + 4 * (i >> 3); }
__device__ __forceinline__ int crow(int r, int hi) { return (r & 3) + 8 * (r >> 2) + 4 * hi; }
__device__ __forceinline__ float sig2(float x) { return __builtin_amdgcn_rcpf(1.f + __builtin_amdgcn_exp2f(-LOG2E * x)); }
__device__ __forceinline__ int opq(int v) { asm volatile("" : "+v"(v)); return v; }
#define MFMA32(a, b, c) __builtin_amdgcn_mfma_f32_32x32x16_bf16((a), (b), (c), 0, 0, 0)

__device__ __forceinline__ void attn_item(const Frame& F, int b, int h, int r, const bf16* P, const bf16* VT, bf16* Y) {
    const int w = F.wave; int lane = opq(F.lane), i = lane & 31, hh = lane >> 5;
    const int rs = min(max(r - 4, 0), 56);
    const LAS float* rpbL = (const LAS float*)(F.lds + RPB_OFF) + h * 465;
    bf16x8 qf[2][4];
    { const bf16* qp = P + (size_t)(b * T + r * 64 + i) * DIN + 1024 + h * 64 + 32 * hh;
#pragma unroll
      for (int qt = 0; qt < 2; ++qt)
#pragma unroll
          for (int s = 0; s < 4; ++s) qf[qt][s] = *(const bf16x8*)(qp + (size_t)qt * 32 * DIN + 8 * s); }
    int tok0[3], krow[3], kc0[3];
#pragma unroll
    for (int j = 0; j < 3; ++j) { const int st = 3 * w + j;
        if (st < 16) { krow[j] = rs + (st >> 1); kc0[j] = 32 * (st & 1); tok0[j] = b * T + krow[j] * 64 + kc0[j]; }
        else { krow[j] = -1; kc0[j] = 0; tok0[j] = ML + b * CT + 32 * (st - 16); } }
    f32x16 S[3][2];
#pragma unroll
    for (int j = 0; j < 3; ++j) {
        lane = opq(F.lane); i = lane & 31; hh = lane >> 5;
        const int kperm = rowperm32(i);
        const bf16* kp = P + (size_t)(tok0[j] + kperm) * DIN + 1536 + h * 64 + 32 * hh;
        bf16x8 kf[4];
#pragma unroll
        for (int s = 0; s < 4; ++s) kf[s] = *(const bf16x8*)(kp + 8 * s);
#pragma unroll
        for (int qt = 0; qt < 2; ++qt) { f32x16 acc = {};
#pragma unroll
            for (int s = 0; s < 4; ++s) acc = MFMA32(kf[s], qf[qt][s], acc);
            S[j][qt] = acc; }
    }
    lane = opq(F.lane); i = lane & 31; hh = lane >> 5;
#pragma unroll
    for (int j = 0; j < 3; ++j) if (krow[j] >= 0) {
        const int rowoff = (krow[j] - r + 7) * 31;
#pragma unroll
        for (int qt = 0; qt < 2; ++qt) { const int qc = 32 * qt + i, cs = min(max(qc - 8, 0), 48);
#pragma unroll
            for (int rr = 0; rr < 16; ++rr) { const int kc = kc0[j] + 16 * hh + rr; const bool valid = (kc >= cs) && (kc < cs + 16);
                const float bias = rpbL[rowoff + (valid ? kc - qc + 15 : 0)];
                S[j][qt][rr] = valid ? S[j][qt][rr] + bias : -1e30f; } }
    }
    LAS f32x2v* mlw = (LAS f32x2v*)(F.lds + ML_OFF);
    bf16x8 pa[3][2][2];
#pragma unroll
    for (int qt = 0; qt < 2; ++qt) {
        float m = -1e30f;
#pragma unroll
        for (int j = 0; j < 3; ++j)
#pragma unroll
            for (int rr = 0; rr < 16; ++rr) m = fmaxf(m, S[j][qt][rr]);
        m = fmaxf(m, __shfl_xor(m, 32));
        float l = 0.f;
#pragma unroll
        for (int j = 0; j < 3; ++j)
#pragma unroll
            for (int s2 = 0; s2 < 2; ++s2) { float pv[8];
#pragma unroll
                for (int e = 0; e < 8; ++e) { pv[e] = __builtin_amdgcn_exp2f(S[j][qt][8 * s2 + e] - m); l += pv[e]; }
                pa[j][qt][s2] = pack8(pv); }
        l += __shfl_xor(l, 32);
        if (hh == 0) mlw[w * 64 + 32 * qt + i] = (f32x2v){m, l};
    }
    f32x16 O[2][2];
#pragma unroll
    for (int qt = 0; qt < 2; ++qt)
#pragma unroll
        for (int dh = 0; dh < 2; ++dh) O[qt][dh] = (f32x16){};
#pragma unroll
    for (int j = 0; j < 3; ++j) {
        lane = opq(F.lane); i = lane & 31; hh = lane >> 5;
        const bf16* vp = VT + (size_t)(h * 64 + i) * MT + tok0[j] + 16 * hh;
        bf16x8 vf[2][2];
#pragma unroll
        for (int dh = 0; dh < 2; ++dh)
#pragma unroll
            for (int s2 = 0; s2 < 2; ++s2) vf[dh][s2] = *(const bf16x8*)(vp + (size_t)dh * 32 * MT + 8 * s2);
#pragma unroll
        for (int qt = 0; qt < 2; ++qt)
#pragma unroll
            for (int s2 = 0; s2 < 2; ++s2)
#pragma unroll
                for (int dh = 0; dh < 2; ++dh) O[qt][dh] = MFMA32(pa[j][qt][s2], vf[dh][s2], O[qt][dh]);
    }
    LDS_WAIT(); __syncthreads();
    lane = opq(F.lane); i = lane & 31; hh = lane >> 5;
    LAS float* facw = (LAS float*)(F.lds + FAC_OFF) + w * 64;
    { float mv[8], lv[8], M = -1e30f;
#pragma unroll
      for (int ww = 0; ww < 8; ++ww) { const f32x2v v = mlw[ww * 64 + lane]; mv[ww] = v.x; lv[ww] = v.y; M = fmaxf(M, v.x); }
      float Ls = 0.f, mine = 0.f;
#pragma unroll
      for (int ww = 0; ww < 8; ++ww) { const float e = __builtin_amdgcn_exp2f(mv[ww] - M); Ls += lv[ww] * e; mine = (ww == w) ? e : mine; }
      facw[lane] = mine / Ls; }
    LDS_WAIT(); asm volatile("" ::: "memory");
    LAS float* slot = (LAS float*)(F.lds + RING_OFF + w * 16384);
#pragma unroll
    for (int qt = 0; qt < 2; ++qt)
#pragma unroll
        for (int rr = 0; rr < 16; ++rr) { const int q = 32 * qt + crow(rr, hh); const float f = facw[q];
#pragma unroll
            for (int dh = 0; dh < 2; ++dh) slot[q * 64 + 32 * dh + i] = O[qt][dh][rr] * f; }
    LDS_WAIT(); __syncthreads();
    lane = opq(F.lane);
    { const int q = 8 * w + (lane >> 3), d8 = (lane & 7) * 8;
      f32x4 a0 = {0.f, 0.f, 0.f, 0.f}, a1 = {0.f, 0.f, 0.f, 0.f};
#pragma unroll
      for (int ww = 0; ww < 8; ++ww) { const LAS f32x4* sp = (const LAS f32x4*)((const LAS float*)(F.lds + RING_OFF + ww * 16384) + q * 64 + d8); a0 += sp[0]; a1 += sp[1]; }
      v4u o; o.x = cvtpk(a0[0], a0[1]); o.y = cvtpk(a0[2], a0[3]); o.z = cvtpk(a1[0], a1[1]); o.w = cvtpk(a1[2], a1[3]);
      *(v4u*)(Y + (size_t)(b * T + r * 64 + q) * D + 512 + h * 64 + d8) = o; }
}

template <bool PASSB>
__device__ __forceinline__ void rglru_item(const Frame& F, int b, int chunk, const bf16* P, const bf16* WG, const float* cw, const float* cb, const float* ba, const float* bx,
                                           const float* lam, float* agg, const float* carry, bf16* Y) {
    const int n = F.wave; int lane = opq(F.lane), i = lane & 31, hh = lane >> 5;
    LAS unsigned char* reg = F.lds + RING_OFF + n * 16384;
    LAS float* cwl = (LAS float*)(reg + 9648);
    LAS unsigned char* ytile = reg + 9648 + 1280;
    int base, Tlen, t0;
    if (chunk < 4) { base = ML + b * CT; Tlen = CT; t0 = chunk * 64; } else { base = b * T; Tlen = T; t0 = (chunk - 4) * 64; }
#pragma unroll
    for (int g = 0; g < 9; ++g) { const int rowi = g * 8 + (lane >> 3), tt = t0 - 2 + rowi; v4u v = {0u, 0u, 0u, 0u};
        if (rowi < 67 && tt >= 0 && tt < Tlen) v = *(const v4u*)(P + (size_t)(base + tt) * DIN + n * 64 + (lane & 7) * 8);
        if (rowi < 67) *(LAS v4u*)(reg + rowi * 144 + (lane & 7) * 16) = v; }
#pragma unroll
    for (int k = 0; k < 4; ++k) cwl[k * 64 + lane] = cw[k * DREC + n * 64 + lane];
    cwl[256 + lane] = cb[n * 64 + lane];
    LDS_WAIT(); asm volatile("" ::: "memory");
    lane = opq(F.lane); i = lane & 31; hh = lane >> 5;
    bf16x8 af[2][4];
#pragma unroll
    for (int m = 0; m < 2; ++m) { const int trow = 32 * m + rowperm32(i);
#pragma unroll
        for (int s = 0; s < 4; ++s) { const int cg = 32 * hh + 8 * s; float xl[8];
            { const f32x4 b0 = *(const LAS f32x4*)(cwl + 256 + cg), b1 = *(const LAS f32x4*)(cwl + 256 + cg + 4);
              xl[0] = b0[0]; xl[1] = b0[1]; xl[2] = b0[2]; xl[3] = b0[3]; xl[4] = b1[0]; xl[5] = b1[1]; xl[6] = b1[2]; xl[7] = b1[3]; }
#pragma unroll
            for (int k = 0; k < 4; ++k) { const v4u xv = *(const LAS v4u*)(reg + (trow + k) * 144 + cg * 2);
                const f32x4 w0 = *(const LAS f32x4*)(cwl + k * 64 + cg), w1 = *(const LAS f32x4*)(cwl + k * 64 + cg + 4);
                xl[0] += w0[0] * lo16(xv.x); xl[1] += w0[1] * hi16(xv.x); xl[2] += w0[2] * lo16(xv.y); xl[3] += w0[3] * hi16(xv.y);
                xl[4] += w1[0] * lo16(xv.z); xl[5] += w1[1] * hi16(xv.z); xl[6] += w1[2] * lo16(xv.w); xl[7] += w1[3] * hi16(xv.w); }
            af[m][s] = pack8(xl); } }
#pragma unroll 1
    for (int dh = 0; dh < 2; ++dh) {
        lane = opq(F.lane); i = lane & 31; hh = lane >> 5;
        int chl = 32 * dh + i, chg = n * 64 + chl;
        float xC[2][16];
        { const float c0 = cwl[chl], c1 = cwl[64 + chl], c2 = cwl[128 + chl], c3 = cwl[192 + chl], cbv = cwl[256 + chl];
#pragma unroll
          for (int m = 0; m < 2; ++m) { float xr[19];
#pragma unroll
              for (int q = 0; q < 19; ++q) xr[q] = bf2f(*(const LAS unsigned short*)(reg + (32 * m + 16 * hh + q) * 144 + chl * 2));
#pragma unroll
              for (int rr = 0; rr < 16; ++rr) xC[m][rr] = cbv + c0 * xr[rr] + c1 * xr[rr + 1] + c2 * xr[rr + 2] + c3 * xr[rr + 3]; } }
        float y[2][16];
#pragma unroll
        for (int d = 0; d < 2; ++d) {
            lane = opq(F.lane); i = lane & 31; hh = lane >> 5; chl = 32 * dh + i; chg = n * 64 + chl;
            bf16x8 wfa[4], wfx[4];
            { const bf16* wpa = WG + (size_t)(d * 8 + n) * 4096 + chl * 64 + 32 * hh; const bf16* wpx = wpa + (size_t)16 * 4096;
#pragma unroll
              for (int s = 0; s < 4; ++s) { wfa[s] = *(const bf16x8*)(wpa + 8 * s); wfx[s] = *(const bf16x8*)(wpx + 8 * s); } }
            const float ba_c = ba[d * DREC + chg], bx_c = bx[d * DREC + chg], lm = lam[d * DREC + chg];
            const float l8 = -8.0f * log1pf(expf(-lm));
            float Hrun = 0.f, Arun = 1.f;
            if (PASSB) Hrun = carry[((size_t)(b * 2 + d) * 64 + (chunk - 4)) * DREC + chg];
#pragma unroll
            for (int mi = 0; mi < 2; ++mi) {
                const int m = d == 0 ? mi : 1 - mi;
                asm volatile("" ::: "memory"); __builtin_amdgcn_sched_barrier(0);
                f32x16 ga = {}, gx = {};
#pragma unroll
                for (int s = 0; s < 4; ++s) { ga = MFMA32(af[m][s], wfa[s], ga); gx = MFMA32(af[m][s], wfx[s], gx); }
#pragma unroll
                for (int rr = 0; rr < 16; ++rr) {
                    const float log_a = l8 * sig2(ga[rr] + ba_c);
                    const float a = __builtin_amdgcn_exp2f(LOG2E * log_a);
                    const float z = 2.0f * log_a;
                    float p = 1.0f / 5040.0f; p = p * z + 1.0f / 720.0f; p = p * z + 1.0f / 120.0f; p = p * z + 1.0f / 24.0f; p = p * z + 1.0f / 6.0f; p = p * z + 0.5f; p = p * z + 1.0f;
                    const float om = z > -0.25f ? -z * p : 1.0f - a * a;
                    ga[rr] = a;
                    gx[rr] = __builtin_amdgcn_sqrtf(om) * sig2(gx[rr] + bx_c) * xC[m][rr];
                }
                float As = 1.f, Bs = 0.f;
                if (d == 0) {
#pragma unroll
                    for (int rr = 0; rr < 16; ++rr) { Bs = ga[rr] * Bs + gx[rr]; As *= ga[rr]; }
                } else {
#pragma unroll
                    for (int rr = 15; rr >= 0; --rr) { Bs = ga[rr] * Bs + gx[rr]; As *= ga[rr]; }
                }
                const float Ap = __shfl_xor(As, 32), Bp = __shfl_xor(Bs, 32);
                const float A0 = hh == 0 ? As : Ap, B0 = hh == 0 ? Bs : Bp, A1 = hh == 1 ? As : Ap, B1 = hh == 1 ? Bs : Bp;
                if (!PASSB) {
                    if (d == 0) { Hrun = A0 * Hrun + B0; Arun *= A0; Hrun = A1 * Hrun + B1; Arun *= A1; }
                    else        { Hrun = A1 * Hrun + B1; Arun *= A1; Hrun = A0 * Hrun + B0; Arun *= A0; }
                } else {
                    float hcur;
                    if (d == 0) { const float c1 = A0 * Hrun + B0; hcur = hh == 0 ? Hrun : c1; Hrun = A1 * c1 + B1; }
                    else        { const float c0 = A1 * Hrun + B1; hcur = hh == 1 ? Hrun : c0; Hrun = A0 * c0 + B0; }
                    if (d == 0) {
#pragma unroll
                        for (int rr = 0; rr < 16; ++rr) { hcur = ga[rr] * hcur + gx[rr]; y[m][rr] = hcur; }
                    } else {
#pragma unroll
                        for (int rr = 15; rr >= 0; --rr) { hcur = ga[rr] * hcur + gx[rr]; y[m][rr] += hcur; }
                    }
                }
            }
            if (!PASSB) { if (hh == 0) *(f32x2v*)(agg + ((size_t)((b * 2 + d) * NCH + chunk) * DREC + chg) * 2) = (f32x2v){Arun, Hrun}; }
        }
        if (PASSB) {
            lane = opq(F.lane); i = lane & 31; hh = lane >> 5; chl = 32 * dh + i;
            bf16x8 idf[4];
#pragma unroll
            for (int s = 0; s < 4; ++s) { v4u wv;
                unsigned e[8];
#pragma unroll
                for (int j = 0; j < 8; ++j) e[j] = (32 * hh + 8 * s + j == chl) ? 0x3F80u : 0u;
                wv.x = e[0] | (e[1] << 16); wv.y = e[2] | (e[3] << 16); wv.z = e[4] | (e[5] << 16); wv.w = e[6] | (e[7] << 16);
                idf[s] = __builtin_bit_cast(bf16x8, wv); }
#pragma unroll
            for (int m = 0; m < 2; ++m) {
                const bf16* gp = P + (size_t)(base + t0 + 32 * m + rowperm32(i)) * DIN + DREC + n * 64 + 32 * hh;
                f32x16 G = {};
#pragma unroll
                for (int s = 0; s < 4; ++s) { const bf16x8 gf = *(const bf16x8*)(gp + 8 * s); G = MFMA32(gf, idf[s], G); }
#pragma unroll
                for (int rr = 0; rr < 16; ++rr) *(LAS unsigned short*)(ytile + (32 * m + 16 * hh + rr) * 80 + i * 2) = (unsigned short)f2bf(y[m][rr] * G[rr]);
            }
            LDS_WAIT(); asm volatile("" ::: "memory");
#pragma unroll
            for (int g = 0; g < 4; ++g) { const int trow = 16 * g + (lane >> 2), ch8 = lane & 3;
                const v4u v = *(const LAS v4u*)(ytile + trow * 80 + ch8 * 16);
                *(v4u*)(Y + (size_t)(base + t0 + trow) * D + n * 64 + 32 * dh + ch8 * 8) = v; }
            LDS_WAIT(); asm volatile("" ::: "memory");
        }
    }
}
__device__ __forceinline__ void phase_carry(const Frame& F, const float* agg, float* carry) {
    const int gt = F.vcu * (NWAVES * 64) + F.tid;
    if (gt >= NB * 2 * DREC) return;
    const int ch = gt % DREC, d = (gt / DREC) & 1, b = gt / (2 * DREC);
    const f32x2v* ag = (const f32x2v*)agg + (size_t)(b * 2 + d) * NCH * DREC + ch;
    float* cr = carry + (size_t)(b * 2 + d) * 64 * DREC + ch;
    float H = 0.f;
    if (d == 0) {
#pragma unroll
        for (int j = 0; j < 4; ++j) { const f32x2v v = ag[(size_t)j * DREC]; H = v.x * H + v.y; }
#pragma unroll 16
        for (int c = 0; c < 64; ++c) { cr[(size_t)c * DREC] = H; const f32x2v v = ag[(size_t)(4 + c) * DREC]; H = v.x * H + v.y; }
    } else {
#pragma unroll
        for (int j = 3; j >= 0; --j) { const f32x2v v = ag[(size_t)j * DREC]; H = v.x * H + v.y; }
#pragma unroll 16
        for (int c = 63; c >= 0; --c) { cr[(size_t)c * DREC] = H; const f32x2v v = ag[(size_t)(4 + c) * DREC]; H = v.x * H + v.y; }
    }
}
__device__ __forceinline__ void stage_rpb(const Frame& F, const float* rpb) {
    LAS float* t = (LAS float*)(F.lds + RPB_OFF);
    for (int e = F.tid; e < 8 * 465; e += NWAVES * 64) t[e] = rpb[e] * LOG2E;
}
struct Args { const float* in[22]; float* out; unsigned char* ws; int ph_lo, ph_hi, li, pad; };
__global__ void __launch_bounds__(NWAVES * 64, 2) mega(Args args) {
    extern __shared__ __attribute__((aligned(16))) unsigned char lds[];
    Frame F;
    F.lds = (LAS unsigned char*)lds;
    F.MISC = (volatile LAS unsigned*)(F.lds + MISC_OFF);
    F.tid = threadIdx.x; F.lane = F.tid & 63; F.wave = __builtin_amdgcn_readfirstlane(F.tid >> 6);
    F.G = gridDim.x; { const int bx = blockIdx.x; F.vcu = (F.G % 8 == 0) ? (bx % 8) * (F.G / 8) + bx / 8 : bx; }
    unsigned char* ws = args.ws;
    F.ctl = (gu32*)(ws + WS_CTL);
    const float* x = args.in[0]; const float* c = args.in[1]; const float* ctx = args.in[2]; const float* cctx = args.in[3];
    const float* wmod = args.in[4]; const float* bmod = args.in[5]; const float* npre = args.in[6]; const float* npost = args.in[7];
    const float* gu1 = args.in[8]; const float* dn1 = args.in[9]; const float* gu2 = args.in[10]; const float* dn2 = args.in[11];
    const float* win = args.in[12]; const float* wout = args.in[13]; const float* cw = args.in[14]; const float* cb = args.in[15];
    const float* wa = args.in[16]; const float* ba = args.in[17]; const float* wx = args.in[18]; const float* bx = args.in[19];
    const float* lam = args.in[20]; const float* rpb = args.in[21];
    float* out = args.out;
    float* mod = (float*)(ws + WS_MOD);
    bf16* WGU1 = (bf16*)(ws + WS_WGU1); bf16* WD1 = (bf16*)(ws + WS_WD1); bf16* WGU2 = (bf16*)(ws + WS_WGU2); bf16* WD2 = (bf16*)(ws + WS_WD2);
    bf16* WIN = (bf16*)(ws + WS_WIN); bf16* WOUT = (bf16*)(ws + WS_WOUT); bf16* WG = (bf16*)(ws + WS_WG);
    float* agg = (float*)(ws + WS_AGG); float* carry = (float*)(ws + WS_CARRY);
    bf16* A = (bf16*)(ws + WS_A); bf16* Y = A; bf16* ACT = (bf16*)(ws + WS_ACT); bf16* P = ACT; float* Fm = (float*)(ws + WS_F); bf16* VT = (bf16*)(ws + WS_VT);

    for (int u = F.tid; u < (LDS_BYTES - LDSCTL_OFF) / 4; u += NWAVES * 64) ((LAS unsigned*)(F.lds + LDSCTL_OFF))[u] = 0u;
    __syncthreads();
    XcdBarrier bar = xcd_barrier_post((unsigned*)(F.ctl + CW_BAR) + args.li * XCD_BAR_WORDS, F.MISC + 8);
    const int lo = args.ph_lo, hi = args.ph_hi;
#define IN(k) (lo <= (k) && (k) < hi)
#define SEAM(k) do { if (IN(k) && IN((k) + 1)) xcd_barrier(bar); } while (0)

    if (IN(0)) {
        if (F.vcu < 36) p0_mod_item(F, c, cctx, wmod, bmod, mod, F.vcu);
        LAS float* scr = (LAS float*)(F.lds + RING_OFF + F.wave * 16384);
        const int gw = F.vcu * NWAVES + F.wave, NGW = F.G * NWAVES;
        constexpr int I_GU = (D / 64) * (2 * DFF / 32), I_DN = (DFF / 64) * (D / 32), I_IN = (D / 64) * (DIN / 32), I_OUT = (D / 64) * (D / 32), I_G = 32 * 2;
        constexpr int NITEMS = 2 * I_GU + 2 * I_DN + I_IN + I_OUT + I_G;
        for (int it = gw; it < NITEMS; it += NGW) {
            int r = it;
            if (r < 2 * I_GU) { const int which = r / I_GU; r -= which * I_GU; const int nblk = 2 * DFF / 32, kb = r / nblk, nb = r % nblk;
                p0_transpose_item(which ? gu2 : gu1, 2 * DFF, D, which ? WGU2 : WGU1, gu_row(32 * nb), 64 * kb, 32 * nb, scr, F.lane); continue; } r -= 2 * I_GU;
            if (r < 2 * I_DN) { const int which = r / I_DN; r -= which * I_DN; const int nblk = D / 32, kb = r / nblk, nb = r % nblk;
                p0_transpose_item(which ? dn2 : dn1, D, DFF, which ? WD2 : WD1, 32 * nb, 64 * kb, 32 * nb, scr, F.lane); continue; } r -= 2 * I_DN;
            if (r < I_IN) { const int nblk = DIN / 32, kb = r / nblk, nb = r % nblk; p0_transpose_item(win, DIN, D, WIN, 32 * nb, 64 * kb, 32 * nb, scr, F.lane); continue; } r -= I_IN;
            if (r < I_OUT) { const int nblk = D / 32, kb = r / nblk, nb = r % nblk; p0_transpose_item(wout, D, D, WOUT, 32 * nb, 64 * kb, 32 * nb, scr, F.lane); continue; } r -= I_OUT;
            { const int mtx = r >> 1, nb = r & 1, gate = mtx >> 4, dn = mtx & 15;
              p0_transpose_item((gate ? wx : wa) + (size_t)dn * 4096, 64, 64, WG + (size_t)mtx * 4096, 32 * nb, 0, 32 * nb, scr, F.lane); }
        }
    }
    SEAM(0);
    if (IN(1)) phase_prenorm(F, x, ctx, mod, 0, npre + 0 * D, A, MT);
    SEAM(1);
    if (IN(2)) { pg8::Gemm g{A, WGU1, MT, 2 * DFF, D}; pg8::StaticOrder S; S.init(MT, 2 * DFF, F.G, (int)blockIdx.x); pg8::EpiSwiGLU E{ACT, DFF};
        pg8::gemm_phase<pg8::EpiSwiGLU, pg8::StaticOrder, true, true>(F.lds + RING_OFF, g, S, E); }
    SEAM(2);
    if (IN(3)) { pg8::Gemm g{ACT, WD1, MT, D, DFF}; pg8::StaticOrder S; S.init(MT, D, F.G, (int)blockIdx.x); pg8::EpiF32 E{Fm, D};
        pg8::gemm_phase<pg8::EpiF32, pg8::StaticOrder, true, true>(F.lds + RING_OFF, g, S, E); }
    SEAM(3);
    if (IN(4)) phase_resnorm(F, Fm, x, ctx, mod, 0, npost + 0 * D, 0.5f, out, 1, npre + 1 * D, A, MT);
    SEAM(4);
    if (IN(5)) { pg8::Gemm g{A, WIN, MT, DIN, D}; pg8::InprojOrder S{F.G, (int)blockIdx.x}; pg8::EpiInproj E{P, VT, DIN, MT, QSCALE};
        pg8::gemm_phase<pg8::EpiInproj, pg8::InprojOrder, true, true>(F.lds + RING_OFF, g, S, E); }
    SEAM(5);
    const int at0 = (int)((long)NB * 8 * 64 * F.vcu / F.G), at1 = (int)((long)NB * 8 * 64 * (F.vcu + 1) / F.G), atm = (at0 + at1) >> 1;
    if (IN(6)) {
        stage_rpb(F, rpb); LDS_WAIT(); __syncthreads();
        for (int id = F.vcu; id < NB * NCH; id += F.G) rglru_item<false>(F, id / NCH, id % NCH, P, WG, cw, cb, ba, bx, lam, agg, carry, Y);
        LDS_WAIT(); __syncthreads();
        for (int it = at0; it < atm; ++it) attn_item(F, it >> 9, (it >> 6) & 7, it & 63, P, VT, Y);
    }
    SEAM(6);
    if (IN(7)) phase_carry(F, agg, carry);
    SEAM(7);
    if (IN(8)) {
        stage_rpb(F, rpb); LDS_WAIT(); __syncthreads();
        for (int id = F.vcu; id < NB * 64; id += F.G) rglru_item<true>(F, id >> 6, 4 + (id & 63), P, WG, cw, cb, ba, bx, lam, agg, carry, Y);
        LDS_WAIT(); __syncthreads();
        for (int it = atm; it < at1; ++it) attn_item(F, it >> 9, (it >> 6) & 7, it & 63, P, VT, Y);
    }
    SEAM(8);
    if (IN(9)) { pg8::Gemm g{Y, WOUT, ML, D, D}; pg8::StaticOrder S; S.init(ML, D, F.G, (int)blockIdx.x); pg8::EpiF32 E{Fm, D};
        pg8::gemm_phase<pg8::EpiF32, pg8::StaticOrder, true, true>(F.lds + RING_OFF, g, S, E); }
    SEAM(9);
    if (IN(10)) phase_resnorm(F, Fm, out, ctx, mod, 1, npost + 1 * D, 1.0f, out, 2, npre + 2 * D, A, ML);
    SEAM(10);
    if (IN(11)) { pg8::Gemm g{A, WGU2, ML, 2 * DFF, D}; pg8::StaticOrder S; S.init(ML, 2 * DFF, F.G, (int)blockIdx.x); pg8::EpiSwiGLU E{ACT, DFF};
        pg8::gemm_phase<pg8::EpiSwiGLU, pg8::StaticOrder, true, true>(F.lds + RING_OFF, g, S, E); }
    SEAM(11);
    if (IN(12)) { pg8::Gemm g{ACT, WD2, ML, D, DFF}; pg8::StaticOrder S; S.init(ML, D, F.G, (int)blockIdx.x); pg8::EpiF32 E{Fm, D};
        pg8::gemm_phase<pg8::EpiF32, pg8::StaticOrder, true, true>(F.lds + RING_OFF, g, S, E); }
    SEAM(12);
    if (IN(13)) phase_resnorm(F, Fm, out, ctx, mod, 2, npost + 2 * D, 0.5f, out, -1, nullptr, nullptr, ML);
#undef IN
#undef SEAM
}

extern "C" void kernel_launch(void* const* d_in, const int* in_sizes, int n_in, void* d_out, int out_size, void* d_ws, size_t ws_size, hipStream_t stream) {
    static int grid = 0;
    if (grid == 0) {
        if (n_in != 22 || in_sizes[0] != ML * D || out_size != ML * D || ws_size < WS_END) { fprintf(stderr, "kernel_launch: unexpected shapes (n_in %d in0 %d out %d ws %zu)\n", n_in, n_in > 0 ? in_sizes[0] : -1, out_size, ws_size); grid = -1; return; }
        int dev = 0, cus = 0;
        if (hipGetDevice(&dev) != hipSuccess || hipDeviceGetAttribute(&cus, hipDeviceAttributeMultiprocessorCount, dev) != hipSuccess) { grid = -1; return; }
        if (hipFuncSetAttribute((const void*)mega, hipFuncAttributeMaxDynamicSharedMemorySize, LDS_BYTES) != hipSuccess) { fprintf(stderr, "kernel_launch: hipFuncSetAttribute failed\n"); grid = -1; return; }
        int per_cu = 0;
        if (hipOccupancyMaxActiveBlocksPerMultiprocessor(&per_cu, (const void*)mega, NWAVES * 64, LDS_BYTES) != hipSuccess || per_cu < 1) fprintf(stderr, "kernel_launch: occupancy query reports %d\n", per_cu);
        (void)hipGetLastError();
        grid = cus;
    }
    if (grid < 0) return;
    (void)hipMemsetAsync((char*)d_ws + WS_CTL, 0, CTL_ZERO_BYTES, stream);
    Args a{};
    for (int i = 0; i < 22; ++i) a.in[i] = (const float*)d_in[i];
    a.out = (float*)d_out; a.ws = (unsigned char*)d_ws;
    a.ph_lo = 0; a.ph_hi = 14; a.li = 0;
    hipLaunchKernelGGL(mega, dim3(grid), dim3(NWAVES * 64), LDS_BYTES, stream, a);
}
```
